# Optimizing an MI355X kernel written in HIP

```python
import jax, jax.numpy as jnp
from jax import lax
import numpy as np

D_MODEL = 1024
BATCH = 8
SEQ = 8192
DEPTH = 1

CHUNK = 64
Q_BLOCK = 128
HEAD_DIM_RWKV = 64
RWKV_DIM = D_MODEL // 2
RWKV_HEADS = RWKV_DIM // HEAD_DIM_RWKV
DECAY_LORA = 64
ICLR_LORA = 64
GATE_LORA = 160
GN_EPS = 64e-5
MLA_HEADS = D_MODEL // 128
Q_LORA = 384
KV_LORA = 256
QK_NOPE = 64
QK_ROPE = 32
V_HEAD = 64
QK_HEAD = QK_NOPE + QK_ROPE
ROPE_THETA = 10000.0
D_FF = 2752
LN_EPS = 1e-5
RMS_EPS = 1e-6
ALPHA = (2.0 * DEPTH) ** 0.25
BETA = (8.0 * DEPTH) ** -0.25
SHIFT_COLS = 3 * RWKV_DIM + DECAY_LORA + ICLR_LORA + GATE_LORA
MLA_COLS = Q_LORA + KV_LORA + QK_ROPE
IN_COLS = SHIFT_COLS + MLA_COLS + 2 * D_MODEL

kernel_name = "hybrid_rwkv7_mla_macaron_deepnorm"


def layer_norm(x, g, b):
    xf = x.astype(jnp.float32)
    mu = jnp.mean(xf, axis=-1, keepdims=True)
    var = jnp.mean(jnp.square(xf - mu), axis=-1, keepdims=True)
    y = (xf - mu) * lax.rsqrt(var + LN_EPS)
    return (y * g.astype(jnp.float32) + b.astype(jnp.float32)).astype(x.dtype)


def rms_norm(x, g):
    xf = x.astype(jnp.float32)
    y = xf * lax.rsqrt(jnp.mean(jnp.square(xf), axis=-1, keepdims=True) + RMS_EPS)
    return (y * g.astype(jnp.float32)).astype(x.dtype)


def swiglu(x, w1, w3, w2):
    return (jax.nn.silu(x @ w1) * (x @ w3)) @ w2


def rope_tables(seq):
    inv_freq = ROPE_THETA ** (-jnp.arange(0, QK_ROPE, 2, dtype=jnp.float32) / QK_ROPE)
    ang = jnp.arange(seq, dtype=jnp.float32)[:, None] * inv_freq[None, :]
    return jnp.cos(ang), jnp.sin(ang)


def apply_rope(x, cos, sin):
    xf = x.astype(jnp.float32)
    x1, x2 = jnp.split(xf, 2, axis=-1)
    return jnp.concatenate([x1 * cos - x2 * sin, x2 * cos + x1 * sin], axis=-1).astype(x.dtype)


def rwkv7_mixer(p, mu_shift, w0, w_decay_up, a0, w_iclr_up, w_gate_up, k_k, k_a, r_k, gn_g, gn_b):
    bsz, seq, _ = p.shape
    h, n = RWKV_HEADS, HEAD_DIM_RWKV
    prev = jnp.pad(p[:, :-1], ((0, 0), (1, 0), (0, 0)))
    p = p + mu_shift * (prev - p)
    r, k, v, wd, ad, gd = jnp.split(
        p, [RWKV_DIM, 2 * RWKV_DIM, 3 * RWKV_DIM, 3 * RWKV_DIM + DECAY_LORA,
            3 * RWKV_DIM + DECAY_LORA + ICLR_LORA], axis=-1)
    w = -jax.nn.softplus(-(w0 + jnp.tanh(wd) @ w_decay_up)) - 0.5
    decay = jnp.exp(-jnp.exp(w.astype(jnp.float32)))
    a = jax.nn.sigmoid(a0 + ad @ w_iclr_up)
    g = jax.nn.sigmoid(gd) @ w_gate_up
    kk = (k * k_k).reshape(bsz, seq, h, n).astype(jnp.float32)
    kk = kk * lax.rsqrt(jnp.maximum(jnp.sum(kk * kk, axis=-1, keepdims=True), 1e-24))
    k = k * (1.0 + (a - 1.0) * k_a)

    def heads(t):
        return t.reshape(bsz, seq, h, n).astype(jnp.float32)

    r_h, k_h, v_h, a_h, w_h = heads(r), heads(k), heads(v), heads(a), heads(decay)

    def step(state, inp):
        r_t, w_t, k_t, v_t, kk_t, b_t = inp
        sa = jnp.einsum('bhvk,bhk->bhv', state, -kk_t)
        state = (state * w_t[:, :, None, :] + sa[..., None] * b_t[:, :, None, :]
                 + v_t[..., None] * k_t[:, :, None, :])
        return state, jnp.einsum('bhvk,bhk->bhv', state, r_t)

    xs = tuple(jnp.moveaxis(t, 1, 0) for t in (r_h, w_h, k_h, v_h, kk, kk * a_h))
    state0 = jnp.zeros((bsz, h, n, n), jnp.float32)
    _, y = lax.scan(step, state0, xs)
    y = jnp.moveaxis(y, 0, 1)
    mu = jnp.mean(y, axis=-1, keepdims=True)
    var = jnp.mean(jnp.square(y - mu), axis=-1, keepdims=True)
    y = ((y - mu) * lax.rsqrt(var + GN_EPS) * gn_g.astype(jnp.float32).reshape(h, n)
         + gn_b.astype(jnp.float32).reshape(h, n))
    bonus = jnp.sum(r_h * k_h * r_k.astype(jnp.float32), axis=-1, keepdims=True) * v_h
    return (y + bonus).reshape(bsz, seq, RWKV_DIM).astype(p.dtype) * g


def mla_mixer(p, q_norm_g, w_q_up, kv_norm_g, w_kv_up):
    bsz, seq, _ = p.shape
    h = MLA_HEADS
    q_lat, kv_lat, k_pe = jnp.split(p, [Q_LORA, Q_LORA + KV_LORA], axis=-1)
    q = (rms_norm(q_lat, q_norm_g) @ w_q_up).reshape(bsz, seq, h, QK_HEAD)
    q_nope, q_pe = jnp.split(q, [QK_NOPE], axis=-1)
    kv = (rms_norm(kv_lat, kv_norm_g) @ w_kv_up).reshape(bsz, seq, h, QK_NOPE + V_HEAD)
    k_nope, v = jnp.split(kv, [QK_NOPE], axis=-1)
    cos, sin = rope_tables(seq)
    q_pe = apply_rope(q_pe, cos[None, :, None, :], sin[None, :, None, :])
    k_pe = apply_rope(k_pe, cos[None], sin[None])
    scale = QK_HEAD ** -0.5
    n_blocks = seq // Q_BLOCK
    qn_b = q_nope.reshape(bsz, n_blocks, Q_BLOCK, h, QK_NOPE).swapaxes(0, 1)
    qp_b = q_pe.reshape(bsz, n_blocks, Q_BLOCK, h, QK_ROPE).swapaxes(0, 1)
    key_chunk = jnp.arange(seq) // CHUNK

    def block(args):
        qn, qp, blk = args
        s = (jnp.einsum('bqhd,bkhd->bhqk', qn, k_nope)
             + jnp.einsum('bqhr,bkr->bhqk', qp, k_pe)).astype(jnp.float32) * scale
        q_chunk = (blk * Q_BLOCK + jnp.arange(Q_BLOCK)) // CHUNK
        mask = key_chunk[None, :] <= q_chunk[:, None]
        s = jnp.where(mask[None, None], s, -jnp.inf)
        prob = jax.nn.softmax(s, axis=-1).astype(v.dtype)
        return jnp.einsum('bhqk,bkhd->bqhd', prob, v)

    o = lax.map(block, (qn_b, qp_b, jnp.arange(n_blocks)))
    return o.swapaxes(0, 1).reshape(bsz, seq, h * V_HEAD)


def setup_inputs(seed: int = 0) -> dict:
    key = jax.random.key(seed)
    ks = jax.random.split(key, 40)
    f32 = jnp.float32

    def nrm(i, shape, scale):
        return scale * jax.random.normal(ks[i], shape, f32)

    L = DEPTH
    w0_base = -6.0 + 5.0 * (jnp.arange(RWKV_DIM, dtype=f32) / (RWKV_DIM - 1)) ** 0.9
    return {
        "x": nrm(0, (BATCH, SEQ, D_MODEL), 1.0),
        "ffn1_w1": nrm(1, (L, D_MODEL, D_FF), D_MODEL ** -0.5),
        "ffn1_w3": nrm(2, (L, D_MODEL, D_FF), D_MODEL ** -0.5),
        "ffn1_w2": nrm(3, (L, D_FF, D_MODEL), BETA * D_FF ** -0.5),
        "ln1_g": 1.0 + nrm(4, (L, D_MODEL), 0.02),
        "ln1_b": nrm(5, (L, D_MODEL), 0.02),
        "w_in": nrm(6, (L, D_MODEL, IN_COLS), D_MODEL ** -0.5),
        "mu_shift": jax.random.uniform(ks[7], (L, SHIFT_COLS), f32),
        "w0": w0_base[None, :] + nrm(8, (L, RWKV_DIM), 0.1),
        "w_decay_up": nrm(9, (L, DECAY_LORA, RWKV_DIM), 0.1 * DECAY_LORA ** -0.5),
        "a0": nrm(10, (L, RWKV_DIM), 0.1),
        "w_iclr_up": nrm(11, (L, ICLR_LORA, RWKV_DIM), ICLR_LORA ** -0.5),
        "w_gate_up": nrm(12, (L, GATE_LORA, RWKV_DIM), GATE_LORA ** -0.5),
        "k_k": 0.85 + nrm(13, (L, RWKV_DIM), 0.05),
        "k_a": 1.0 + nrm(14, (L, RWKV_DIM), 0.05),
        "r_k": nrm(15, (L, RWKV_HEADS, HEAD_DIM_RWKV), 0.1),
        "gn_g": 1.0 + nrm(16, (L, RWKV_DIM), 0.02),
        "gn_b": nrm(17, (L, RWKV_DIM), 0.02),
        "q_norm_g": 1.0 + nrm(18, (L, Q_LORA), 0.02),
        "w_q_up": nrm(19, (L, Q_LORA, MLA_HEADS * QK_HEAD), Q_LORA ** -0.5),
        "kv_norm_g": 1.0 + nrm(20, (L, KV_LORA), 0.02),
        "w_kv_up": nrm(21, (L, KV_LORA, MLA_HEADS * (QK_NOPE + V_HEAD)), KV_LORA ** -0.5),
        "w_up_rwkv": nrm(22, (L, RWKV_DIM, D_MODEL), RWKV_DIM ** -0.5),
        "w_up_mla": nrm(23, (L, MLA_HEADS * V_HEAD, D_MODEL), (MLA_HEADS * V_HEAD) ** -0.5),
        "w_o": nrm(24, (L, D_MODEL, D_MODEL), BETA * D_MODEL ** -0.5),
        "ln2_g": 1.0 + nrm(25, (L, D_MODEL), 0.02),
        "ln2_b": nrm(26, (L, D_MODEL), 0.02),
        "ffn2_w1": nrm(27, (L, D_MODEL, D_FF), D_MODEL ** -0.5),
        "ffn2_w3": nrm(28, (L, D_MODEL, D_FF), D_MODEL ** -0.5),
        "ffn2_w2": nrm(29, (L, D_FF, D_MODEL), BETA * D_FF ** -0.5),
        "ln3_g": 1.0 + nrm(30, (L, D_MODEL), 0.02),
        "ln3_b": nrm(31, (L, D_MODEL), 0.02),
    }


def reference(x, ffn1_w1, ffn1_w3, ffn1_w2, ln1_g, ln1_b,
              w_in, mu_shift, w0, w_decay_up, a0, w_iclr_up, w_gate_up, k_k, k_a, r_k, gn_g, gn_b,
              q_norm_g, w_q_up, kv_norm_g, w_kv_up,
              w_up_rwkv, w_up_mla, w_o, ln2_g, ln2_b,
              ffn2_w1, ffn2_w3, ffn2_w2, ln3_g, ln3_b):
    h = x
    for l in range(DEPTH):
        h = layer_norm(ALPHA * h + 0.5 * swiglu(h, ffn1_w1[l], ffn1_w3[l], ffn1_w2[l]), ln1_g[l], ln1_b[l])
        proj = h @ w_in[l]
        p_shift, p_mla, gate_logits = jnp.split(proj, [SHIFT_COLS, SHIFT_COLS + MLA_COLS], axis=-1)
        y_rwkv = rwkv7_mixer(p_shift, mu_shift[l], w0[l], w_decay_up[l], a0[l], w_iclr_up[l],
                             w_gate_up[l], k_k[l], k_a[l], r_k[l], gn_g[l], gn_b[l]) @ w_up_rwkv[l]
        y_mla = mla_mixer(p_mla, q_norm_g[l], w_q_up[l], kv_norm_g[l], w_kv_up[l]) @ w_up_mla[l]
        g_rwkv, g_mla = jnp.split(jax.nn.sigmoid(gate_logits), 2, axis=-1)
        mix = (g_rwkv * y_rwkv + g_mla * y_mla) @ w_o[l]
        h = layer_norm(ALPHA * h + mix, ln2_g[l], ln2_b[l])
        h = layer_norm(ALPHA * h + 0.5 * swiglu(h, ffn2_w1[l], ffn2_w3[l], ffn2_w2[l]), ln3_g[l], ln3_b[l])
    return h
```

```cpp
#include <hip/hip_runtime.h>
#include <hip/hip_cooperative_groups.h>
#include <cstdio>
#include <cstdint>
namespace cg = cooperative_groups;

#define LAS __attribute__((address_space(3)))
typedef unsigned short bf16_t;
typedef short bf16x8 __attribute__((ext_vector_type(8)));
typedef float f32x4 __attribute__((ext_vector_type(4)));
typedef float f32x16 __attribute__((ext_vector_type(16)));
typedef unsigned u32x4 __attribute__((ext_vector_type(4)));
typedef unsigned u32x2 __attribute__((ext_vector_type(2)));

constexpr int T_TOK = 65536, SEQ = 8192, DM = 1024, DFF = 2752, DFFP = 2816, NFF1 = 5632;
constexpr int IN_COLS = 4544, PROJ_LD = 2560, NGATE = 2048;
constexpr float ALPHA = 1.189207115002721f;
constexpr int LDS_MAIN = 131072;
constexpr int LDS_BYTES = LDS_MAIN + 64;

constexpr size_t MiB = 1ull << 20;
constexpr size_t OFF_W13_1 = 0;
constexpr size_t OFF_W2_1  = OFF_W13_1 + (size_t)NFF1 * DM * 2;
constexpr size_t OFF_W13_2 = OFF_W2_1 + (size_t)DM * DFFP * 2;
constexpr size_t OFF_W2_2  = OFF_W13_2 + (size_t)NFF1 * DM * 2;
constexpr size_t OFF_WIN   = OFF_W2_2 + (size_t)DM * DFFP * 2;
constexpr size_t OFF_WLORA = OFF_WIN + (size_t)4608 * DM * 2;
constexpr size_t OFF_WQ    = OFF_WLORA + (size_t)1536 * 384 * 2;
constexpr size_t OFF_WKV   = OFF_WQ + (size_t)768 * 384 * 2;
constexpr size_t OFF_WUR   = OFF_WKV + (size_t)1024 * 256 * 2;
constexpr size_t OFF_WUM   = OFF_WUR + (size_t)1024 * 512 * 2;
constexpr size_t OFF_WO    = OFF_WUM + (size_t)1024 * 512 * 2;
constexpr size_t OFF_ROPE  = OFF_WO + (size_t)1024 * 1024 * 2;
constexpr size_t OFF_CTL   = OFF_ROPE + (size_t)2 * 8192 * 16 * 4;
constexpr size_t OFF_BAR   = OFF_CTL + 4096;
constexpr size_t CTL_BYTES = 4096 + 3456 * 4;
constexpr size_t OFF_STAT1 = OFF_CTL + 32768;
constexpr size_t OFF_STAT2 = OFF_STAT1 + (size_t)65536 * 8;
constexpr size_t OFF_R1    = 56 * MiB;
constexpr size_t OFF_R2    = 184 * MiB;
constexpr size_t OFF_R3    = 536 * MiB;
constexpr size_t OFF_R4    = 856 * MiB;
static_assert(OFF_STAT2 + (size_t)65536 * 8 <= OFF_R1 && CTL_BYTES <= 32768, "weights overflow");

struct Params { const float* in[32]; float* out; unsigned char* ws; };

enum { I_X = 0, I_F1W1, I_F1W3, I_F1W2, I_LN1G, I_LN1B, I_WIN, I_MU, I_W0, I_WDU, I_A0, I_WIU, I_WGU, I_KK, I_KA, I_RK, I_GNG, I_GNB,
       I_QNG, I_WQU, I_KVNG, I_WKVU, I_WUR, I_WUM, I_WO, I_LN2G, I_LN2B, I_F2W1, I_F2W3, I_F2W2, I_LN3G, I_LN3B };

typedef __bf16 bf16v2_t __attribute__((ext_vector_type(2)));
typedef float f32v2_t __attribute__((ext_vector_type(2)));
__device__ __forceinline__ unsigned cvt_pk_bf16(float lo, float hi) { f32v2_t v = {lo, hi}; bf16v2_t b = __builtin_convertvector(v, bf16v2_t); return __builtin_bit_cast(unsigned, b); }
__device__ __forceinline__ float bflo(unsigned w) { return __uint_as_float(w << 16); }
__device__ __forceinline__ float bfhi(unsigned w) { return __uint_as_float(w & 0xffff0000u); }
__device__ __forceinline__ int otid(int wsg) { int l; asm volatile("v_mbcnt_lo_u32_b32 %0, -1, 0\n\tv_mbcnt_hi_u32_b32 %0, -1, %0" : "=v"(l)); return wsg * 64 + l; }
__device__ __forceinline__ float shx(float v, int lane, int m) { return __int_as_float(__builtin_amdgcn_ds_bpermute((lane ^ m) << 2, __float_as_int(v))); }
__device__ __forceinline__ float bf2f(bf16_t b) { return __uint_as_float(((unsigned)b) << 16); }

namespace pg8 {
constexpr int BM = 256, BK = 64, HALF = 128, HTB = HALF * BK * 2, STAGE_BYTES = 8 * HTB, NXCD = 8, WGM = 8;
__host__ __device__ __forceinline__ int lds_byte(int r, int c) { const int st = (r >> 4) * 2 + (c >> 5), rr = r & 15, cc = c & 31, ob = rr * 64 + cc * 2; return st * 1024 + (ob ^ (((ob >> 9) & 1) << 5)); }
__host__ __device__ __forceinline__ void stage_rc(int b, int& R, int& C) { const int st = b / 1024, sb = b % 1024, swz = sb ^ (((sb >> 9) & 1) << 5); R = (st >> 1) * 16 + swz / 64; C = (st & 1) * 32 + (swz % 64) / 2; }
__host__ __device__ __forceinline__ int perm32(int rho) { const int n = rho >> 4, i = rho & 15; return 8 * (i >> 2) + 4 * n + (i & 3); }
struct Unit { int pm, pn; };
struct Gemm { const bf16_t* A; int lda; const bf16_t* Bt; int M, N, K; };
struct StaticOrder {
    int nM, nN, nwg, G, c;
    __device__ void init(int M, int N, int G_, int c_) { nM = M / BM; nN = N / BM; nwg = nM * nN; G = G_; c = c_; }
    __device__ bool next(int i, Unit& u) const {
        const long L = (long)i * G + c; if (L >= nwg) return false;
        int wgid = (int)L; { const int q = nwg / NXCD, r = nwg % NXCD, xcd = wgid % NXCD, off = wgid / NXCD; wgid = (xcd < r ? xcd * (q + 1) : r * (q + 1) + (xcd - r) * q) + off; }
        const int nig = WGM * nN, gid = wgid / nig, fm = gid * WGM, gsz = (nM - fm) < WGM ? (nM - fm) : WGM;
        u.pm = fm + ((wgid % nig) % gsz); u.pn = (wgid % nig) / gsz; return true;
    }
};

template <int N_, int K_, int LDA_, class Epi>
__device__ __forceinline__ void gemm_phase(int wsg, LAS unsigned char* lds, const bf16_t* gA, const bf16_t* gBt, const Epi& E) {
    struct { const bf16_t* A; const bf16_t* Bt; } g{gA, gBt};
    StaticOrder S; S.init(T_TOK, N_, (int)gridDim.x, (int)blockIdx.x);
    const int tid_ = otid(wsg);
    const int tid = tid_, wid = __builtin_amdgcn_readfirstlane(tid >> 6), lane = tid & 63, wr = wid >> 2, wc = wid & 3, fr = lane & 15, fq = lane >> 4;
    constexpr int K = K_, nt = K / BK, lda = LDA_;
    unsigned voffA[2], voffB[2];
#pragma unroll
    for (int i = 0; i < 2; ++i) { int R, C; stage_rc(tid * 16 + i * 8192, R, C); const int Rb = Epi::PERM ? ((R & ~31) + perm32(R & 31)) : R;
        voffA[i] = (unsigned)(R * lda + C) * 2u; voffB[i] = (unsigned)(Rb * K + C) * 2u; }
    constexpr size_t kstep = (size_t)(BK * 2);
    constexpr size_t hstepA = (size_t)HALF * lda * 2, hstepB = (size_t)HALF * K * 2;
    constexpr size_t tstepA = 2 * hstepA, tstepB = 2 * hstepB;
    const unsigned ldsw = (unsigned)wid * 1024u;
    const int aoff = lds_byte(wr * 64 + fr, fq * 8), boff = lds_byte(wc * 32 + fr, fq * 8);
#define PG8_SA(b, h) (((b) * 2 + (h)) * HTB)
#define PG8_SB(b, h) ((4 + (b) * 2 + (h)) * HTB)
#define PG8_STAGE(bufoff, gbase, voff) do { _Pragma("unroll") for (int _i = 0; _i < 2; ++_i) \
        __builtin_amdgcn_global_load_lds((const unsigned*)((const char*)(gbase) + (voff)[_i]), (LAS unsigned*)(lds + (bufoff) + ldsw + _i * 8192), 16, 0, 0); } while (0)
#define PG8_LDA(dst, b, h) do { _Pragma("unroll") for (int m = 0; m < 4; ++m) _Pragma("unroll") for (int k = 0; k < 2; ++k) dst[m][k] = *(const LAS bf16x8*)(lds + PG8_SA(b, h) + aoff + m * 2048 + k * 1024); } while (0)
#define PG8_LDB(dst, b, h) do { _Pragma("unroll") for (int n = 0; n < 2; ++n) _Pragma("unroll") for (int k = 0; k < 2; ++k) dst[n][k] = *(const LAS bf16x8*)(lds + PG8_SB(b, h) + boff + n * 2048 + k * 1024); } while (0)
#define PG8_MMA(ai, bj, At, Bt) do { __builtin_amdgcn_s_setprio(1); _Pragma("unroll") for (int m = 0; m < 4; ++m) _Pragma("unroll") for (int n = 0; n < 2; ++n) _Pragma("unroll") for (int k = 0; k < 2; ++k) \
        acc[ai][bj][m][n] = __builtin_amdgcn_mfma_f32_16x16x32_bf16(Bt[n][k], At[m][k], acc[ai][bj][m][n], 0, 0, 0); __builtin_amdgcn_s_setprio(0); } while (0)
#define PG8_WAIT_V(n) asm volatile("s_waitcnt vmcnt(" #n ")" ::: "memory")
#define PG8_WAIT_L(n) asm volatile("s_waitcnt lgkmcnt(" #n ")" ::: "memory")
#define PG8_BAR __builtin_amdgcn_s_barrier()
#define PG8_SCHED __builtin_amdgcn_sched_barrier(0)
    Unit cur, nxt; int ui = 0;
    if (!S.next(0, cur)) return;
    f32x4 acc[2][2][4][2];
#pragma unroll
    for (int a = 0; a < 2; ++a)
#pragma unroll
        for (int b = 0; b < 2; ++b)
#pragma unroll
            for (int m = 0; m < 4; ++m)
#pragma unroll
                for (int n = 0; n < 2; ++n) acc[a][b][m][n] = (f32x4){0.f, 0.f, 0.f, 0.f};
    bf16x8 At[4][2], B0[2][2], B1[2][2];
    const char* cA = (const char*)g.A + (size_t)cur.pm * tstepA; const char* cB = (const char*)g.Bt + (size_t)cur.pn * tstepB;
    PG8_STAGE(PG8_SB(0, 0), cB, voffB); PG8_STAGE(PG8_SB(0, 1), cB + hstepB, voffB); PG8_STAGE(PG8_SA(0, 0), cA, voffA); PG8_STAGE(PG8_SA(0, 1), cA + hstepA, voffA);
    if (wr == 1) PG8_BAR;
    PG8_WAIT_V(2); PG8_BAR;
    PG8_STAGE(PG8_SB(1, 0), cB + kstep, voffB); PG8_STAGE(PG8_SA(1, 0), cA + kstep, voffA); PG8_STAGE(PG8_SB(1, 1), cB + hstepB + kstep, voffB);
    PG8_WAIT_V(6); PG8_BAR;
    for (;;) {
        const bool has_next = S.next(ui + 1, nxt);
        const char* nA = has_next ? (const char*)g.A + (size_t)nxt.pm * tstepA : cA; const char* nB = has_next ? (const char*)g.Bt + (size_t)nxt.pn * tstepB : cB;
#pragma unroll 1
        for (int t = 0; t < nt; t += 2) {
            const bool last = (t == nt - 2);
            const char* a1 = cA + (size_t)(t + 1) * kstep;
            const char* a2 = last ? nA : cA + (size_t)(t + 2) * kstep; const char* b2 = last ? nB : cB + (size_t)(t + 2) * kstep;
            const char* a3 = a2 + kstep; const char* b3 = b2 + kstep;
            PG8_LDB(B0, 0, 0); PG8_LDB(B1, 0, 1); PG8_SCHED; PG8_LDA(At, 0, 0); PG8_STAGE(PG8_SA(1, 1), a1 + hstepA, voffA);
            PG8_WAIT_V(8); PG8_WAIT_L(0); PG8_BAR; PG8_MMA(0, 0, At, B0); PG8_MMA(0, 1, At, B1); PG8_BAR; PG8_SCHED;
            PG8_LDA(At, 0, 1); PG8_STAGE(PG8_SB(0, 0), b2, voffB); PG8_STAGE(PG8_SB(0, 1), b2 + hstepB, voffB); PG8_STAGE(PG8_SA(0, 0), a2, voffA);
            PG8_WAIT_V(8); PG8_WAIT_L(0); PG8_BAR; PG8_MMA(1, 0, At, B0); PG8_MMA(1, 1, At, B1); PG8_BAR; PG8_SCHED;
            PG8_LDB(B0, 1, 0); PG8_LDB(B1, 1, 1); PG8_SCHED; PG8_LDA(At, 1, 0); PG8_STAGE(PG8_SA(0, 1), a2 + hstepA, voffA);
            PG8_WAIT_V(8); PG8_WAIT_L(0); PG8_BAR; PG8_MMA(0, 0, At, B0); PG8_MMA(0, 1, At, B1); PG8_BAR; PG8_SCHED;
            PG8_LDA(At, 1, 1); PG8_STAGE(PG8_SB(1, 0), b3, voffB); PG8_STAGE(PG8_SB(1, 1), b3 + hstepB, voffB); PG8_STAGE(PG8_SA(1, 0), a3, voffA);
            PG8_WAIT_V(8); PG8_WAIT_L(0); PG8_BAR; PG8_MMA(1, 0, At, B0); PG8_MMA(1, 1, At, B1); PG8_BAR; PG8_SCHED;
        }
        if (wr == 0) PG8_BAR;
        E(acc, cur, wr, wc, fr, fq);
        if (!has_next) break;
#pragma unroll
        for (int a = 0; a < 2; ++a)
#pragma unroll
            for (int b = 0; b < 2; ++b)
#pragma unroll
                for (int m = 0; m < 4; ++m)
#pragma unroll
                    for (int n = 0; n < 2; ++n) acc[a][b][m][n] = (f32x4){0.f, 0.f, 0.f, 0.f};
        cur = nxt; cA = nA; cB = nB; ++ui;
        if (wr == 1) PG8_BAR;
    }
    PG8_WAIT_V(0);
    PG8_BAR;
#undef PG8_SA
#undef PG8_SB
#undef PG8_STAGE
#undef PG8_LDA
#undef PG8_LDB
#undef PG8_MMA
#undef PG8_WAIT_V
#undef PG8_WAIT_L
#undef PG8_BAR
#undef PG8_SCHED
}
}
using pg8::Unit;


struct EpiSwiGLU {
    static constexpr bool PERM = true;
    bf16_t* O;
    __device__ __forceinline__ void operator()(const f32x4 (&acc)[2][2][4][2], const Unit& u, int wr, int wc, int fr, int fq) const {
        const int row0 = u.pm * 256 + wr * 64 + fr, col0 = u.pn * 128 + wc * 32 + 8 * fq;
#pragma unroll
        for (int ai = 0; ai < 2; ++ai)
#pragma unroll
            for (int m = 0; m < 4; ++m) {
                float h[8];
#pragma unroll
                for (int n = 0; n < 2; ++n)
#pragma unroll
                    for (int j = 0; j < 4; ++j) { const float gt = acc[ai][0][m][n][j], up = acc[ai][1][m][n][j]; h[n * 4 + j] = gt * up * __builtin_amdgcn_rcpf(1.0f + __builtin_amdgcn_exp2f(-gt)); }
                u32x4 w; w.x = cvt_pk_bf16(h[0], h[1]); w.y = cvt_pk_bf16(h[2], h[3]); w.z = cvt_pk_bf16(h[4], h[5]); w.w = cvt_pk_bf16(h[6], h[7]);
                *(u32x4*)(O + (size_t)(row0 + ai * 128 + m * 16) * DFFP + col0) = w;
            }
    }
};
struct EpiResid {
    static constexpr bool PERM = false;
    const float* res; float* out; float sc;
    __device__ __forceinline__ void operator()(const f32x4 (&acc)[2][2][4][2], const Unit& u, int wr, int wc, int fr, int fq) const {
        const int row0 = u.pm * 256 + wr * 64 + fr, col0 = u.pn * 256 + wc * 32 + 4 * fq;
#pragma unroll
        for (int ai = 0; ai < 2; ++ai)
#pragma unroll
            for (int m = 0; m < 4; ++m) {
                const size_t ro = (size_t)(row0 + ai * 128 + m * 16) * DM + col0;
                f32x4 rv[2][2];
#pragma unroll
                for (int bj = 0; bj < 2; ++bj)
#pragma unroll
                    for (int n = 0; n < 2; ++n) rv[bj][n] = *(const f32x4*)(res + ro + bj * 128 + n * 16);
#pragma unroll
                for (int bj = 0; bj < 2; ++bj)
#pragma unroll
                    for (int n = 0; n < 2; ++n) *(f32x4*)(out + ro + bj * 128 + n * 16) = rv[bj][n] * ALPHA + acc[ai][bj][m][n] * sc;
            }
    }
};


constexpr float QSCALE = 0.10206207261596575f * 1.4426950408889634f;
template <int MODE  > struct EpiBf16Store {
    static constexpr bool PERM = true;
    bf16_t* O; int ldc;
    __device__ __forceinline__ void operator()(const f32x4 (&acc)[2][2][4][2], const Unit& u, int wr, int wc, int fr, int fq) const {
        const int row0 = u.pm * 256 + wr * 64 + fr, col0 = u.pn * 256 + wc * 32 + 8 * fq;
#pragma unroll
        for (int ai = 0; ai < 2; ++ai)
#pragma unroll
            for (int m = 0; m < 4; ++m)
#pragma unroll
                for (int bj = 0; bj < 2; ++bj) {
                    float h[8];
#pragma unroll
                    for (int n = 0; n < 2; ++n)
#pragma unroll
                        for (int j = 0; j < 4; ++j) { const float v = acc[ai][bj][m][n][j]; h[n * 4 + j] = MODE == 1 ? __builtin_amdgcn_rcpf(1.0f + __builtin_amdgcn_exp2f(-v)) : (MODE == 2 ? v * QSCALE : v); }
                    u32x4 w; w.x = cvt_pk_bf16(h[0], h[1]); w.y = cvt_pk_bf16(h[2], h[3]); w.z = cvt_pk_bf16(h[4], h[5]); w.w = cvt_pk_bf16(h[6], h[7]);
                    __builtin_nontemporal_store(w, (u32x4*)(O + (size_t)(row0 + ai * 128 + m * 16) * ldc + col0 + bj * 128));
                }
    }
};
struct EpiKV {
    static constexpr bool PERM = true;
    bf16_t* KN; bf16_t* VT;
    __device__ __forceinline__ void operator()(const f32x4 (&acc)[2][2][4][2], const Unit& u, int wr, int wc, int fr, int fq) const {
        const int row0 = u.pm * 256 + wr * 64 + fr, col0 = u.pn * 256 + wc * 32 + 8 * fq;
#pragma unroll
        for (int ai = 0; ai < 2; ++ai)
#pragma unroll
            for (int m = 0; m < 4; ++m) {
                const int row = row0 + ai * 128 + m * 16, pos = row & (SEQ - 1), b = row >> 13;
#pragma unroll
                for (int bj = 0; bj < 2; ++bj) {
                    const int c0 = col0 + bj * 128, hd = c0 >> 7, within = c0 & 127;
                    float h[8];
#pragma unroll
                    for (int n = 0; n < 2; ++n)
#pragma unroll
                        for (int j = 0; j < 4; ++j) h[n * 4 + j] = acc[ai][bj][m][n][j];
                    u32x4 w; w.x = cvt_pk_bf16(h[0], h[1]); w.y = cvt_pk_bf16(h[2], h[3]); w.z = cvt_pk_bf16(h[4], h[5]); w.w = cvt_pk_bf16(h[6], h[7]);
                    if (within < 64) { *(u32x4*)(KN + (size_t)row * 512 + hd * 64 + within) = w; }
                    else {
                        bf16_t* vp = VT + ((size_t)((b * 8 + hd) * 64 + (within - 64))) * SEQ + pos;
                        vp[0 * SEQ] = (bf16_t)(w.x & 0xffffu); vp[1 * SEQ] = (bf16_t)(w.x >> 16); vp[2 * SEQ] = (bf16_t)(w.y & 0xffffu); vp[3 * SEQ] = (bf16_t)(w.y >> 16);
                        vp[4 * SEQ] = (bf16_t)(w.z & 0xffffu); vp[5 * SEQ] = (bf16_t)(w.z >> 16); vp[6 * SEQ] = (bf16_t)(w.w & 0xffffu); vp[7 * SEQ] = (bf16_t)(w.w >> 16);
                    }
                }
            }
    }
};
template <int MODE> struct EpiUp {
    static constexpr bool PERM = true;
    bf16_t* U; const bf16_t* G; int goff;
    __device__ __forceinline__ void operator()(const f32x4 (&acc)[2][2][4][2], const Unit& u, int wr, int wc, int fr, int fq) const {
        const int row0 = u.pm * 256 + wr * 64 + fr, col0 = u.pn * 256 + wc * 32 + 8 * fq;
#pragma unroll
        for (int ai = 0; ai < 2; ++ai)
#pragma unroll
            for (int m = 0; m < 4; ++m)
#pragma unroll
                for (int bj = 0; bj < 2; ++bj) {
                    const size_t row = (size_t)(row0 + ai * 128 + m * 16); const int c0 = col0 + bj * 128;
                    const u32x4 gw = *(const u32x4*)(G + row * NGATE + goff + c0);
                    float h[8];
#pragma unroll
                    for (int n = 0; n < 2; ++n)
#pragma unroll
                        for (int j = 0; j < 4; ++j) h[n * 4 + j] = acc[ai][bj][m][n][j];
                    h[0] *= bflo(gw.x); h[1] *= bfhi(gw.x); h[2] *= bflo(gw.y); h[3] *= bfhi(gw.y); h[4] *= bflo(gw.z); h[5] *= bfhi(gw.z); h[6] *= bflo(gw.w); h[7] *= bfhi(gw.w);
                    if (MODE == 1) { const u32x4 uw = *(const u32x4*)(U + row * DM + c0);
                        h[0] += bflo(uw.x); h[1] += bfhi(uw.x); h[2] += bflo(uw.y); h[3] += bfhi(uw.y); h[4] += bflo(uw.z); h[5] += bfhi(uw.z); h[6] += bflo(uw.w); h[7] += bfhi(uw.w); }
                    u32x4 w; w.x = cvt_pk_bf16(h[0], h[1]); w.y = cvt_pk_bf16(h[2], h[3]); w.z = cvt_pk_bf16(h[4], h[5]); w.w = cvt_pk_bf16(h[6], h[7]);
                    *(u32x4*)(U + row * DM + c0) = w;
                }
    }
};

typedef _Float16 f16v2_t __attribute__((ext_vector_type(2)));
__device__ __forceinline__ unsigned cvt_pk_f16(float lo, float hi) { f32v2_t v = {lo, hi}; f16v2_t b = __builtin_convertvector(v, f16v2_t); return __builtin_bit_cast(unsigned, b); }
__device__ __forceinline__ float f16lo(unsigned w) { f16v2_t b = __builtin_bit_cast(f16v2_t, w); return (float)b[0]; }
__device__ __forceinline__ float f16hi(unsigned w) { f16v2_t b = __builtin_bit_cast(f16v2_t, w); return (float)b[1]; }
template <int KIND> struct EpiLora {
    static constexpr bool PERM = true;
    unsigned short* O; const float* bias;
    __device__ __forceinline__ void operator()(const f32x4 (&acc)[2][2][4][2], const Unit& u, int wr, int wc, int fr, int fq) const {
        const int row0 = u.pm * 256 + wr * 64 + fr, col0 = u.pn * 256 + wc * 32 + 8 * fq;
#pragma unroll
        for (int ai = 0; ai < 2; ++ai)
#pragma unroll
            for (int m = 0; m < 4; ++m)
#pragma unroll
                for (int bj = 0; bj < 2; ++bj) {
                    const int c0 = col0 + bj * 128;
                    f32x4 b0 = (f32x4){0.f, 0.f, 0.f, 0.f}, b1 = b0;
                    if (KIND != 2) { b0 = *(const f32x4*)(bias + c0); b1 = *(const f32x4*)(bias + c0 + 4); }
                    float h[8];
#pragma unroll
                    for (int n = 0; n < 2; ++n)
#pragma unroll
                        for (int j = 0; j < 4; ++j) {
                            const float x = acc[ai][bj][m][n][j] + (n == 0 ? b0[j] : b1[j]);
                            float o;
                            if (KIND == 0) o = 0.6065306597126334f * __builtin_amdgcn_rcpf(1.0f + __expf(-x));
                            else if (KIND == 1) o = __builtin_amdgcn_rcpf(1.0f + __expf(-x));
                            else o = x;
                            h[n * 4 + j] = o;
                        }
                    u32x4 w; w.x = cvt_pk_f16(h[0], h[1]); w.y = cvt_pk_f16(h[2], h[3]); w.z = cvt_pk_f16(h[4], h[5]); w.w = cvt_pk_f16(h[6], h[7]);
                    *(u32x4*)(O + (size_t)(row0 + ai * 128 + m * 16) * 1536 + c0) = w;
                }
    }
};

struct EpiResidLN {
    static constexpr bool PERM = false;
    const float* z; float* out; float sc; const float* stat; const float* g; const float* b;
    __device__ __forceinline__ void operator()(const f32x4 (&acc)[2][2][4][2], const Unit& u, int wr, int wc, int fr, int fq) const {
        const int row0 = u.pm * 256 + wr * 64 + fr, col0 = u.pn * 256 + wc * 32 + 4 * fq;
#pragma unroll
        for (int ai = 0; ai < 2; ++ai)
#pragma unroll
            for (int m = 0; m < 4; ++m) {
                __builtin_amdgcn_sched_barrier(0);
                const int row = row0 + ai * 128 + m * 16;
                const size_t ro = (size_t)row * DM + col0;
                const float mu = stat[2 * row], rs = stat[2 * row + 1];
#pragma unroll
                for (int bj = 0; bj < 2; ++bj)
#pragma unroll
                    for (int n = 0; n < 2; ++n) {
                        const f32x4 zv = *(const f32x4*)(z + ro + bj * 128 + n * 16);
                        const f32x4 gv = *(const f32x4*)(g + col0 + bj * 128 + n * 16), bv = *(const f32x4*)(b + col0 + bj * 128 + n * 16);
                        const f32x4 h = (zv - mu) * rs * gv + bv;
                        *(f32x4*)(out + ro + bj * 128 + n * 16) = h * ALPHA + acc[ai][bj][m][n] * sc;
                    }
            }
    }
};

struct EpiZ1 {
    static constexpr bool PERM = true;
    const float* x; bf16_t* z; float sc;
    __device__ __forceinline__ void operator()(const f32x4 (&acc)[2][2][4][2], const Unit& u, int wr, int wc, int fr, int fq) const {
        const int row0 = u.pm * 256 + wr * 64 + fr, col0 = u.pn * 256 + wc * 32 + 8 * fq;
#pragma unroll
        for (int ai = 0; ai < 2; ++ai)
#pragma unroll
            for (int m = 0; m < 4; ++m) {
#pragma unroll
                for (int bj = 0; bj < 2; ++bj) {
                    const size_t o = (size_t)(row0 + ai * 128 + m * 16) * DM + col0 + bj * 128;
                    const f32x4 x0 = *(const f32x4*)(x + o), x1 = *(const f32x4*)(x + o + 4);
                    const f32x4 r0 = x0 * ALPHA + acc[ai][bj][m][0] * sc, r1 = x1 * ALPHA + acc[ai][bj][m][1] * sc;
                    u32x4 w; w.x = cvt_pk_bf16(r0[0], r0[1]); w.y = cvt_pk_bf16(r0[2], r0[3]); w.z = cvt_pk_bf16(r1[0], r1[1]); w.w = cvt_pk_bf16(r1[2], r1[3]);
                    __builtin_nontemporal_store(w, (u32x4*)(z + o));
                }
            }
    }
};
struct EpiZLN {
    static constexpr bool PERM = true;
    const bf16_t* zin; bf16_t* zout; float sc; const float* stat; const float* g; const float* b;
    __device__ __forceinline__ void operator()(const f32x4 (&acc)[2][2][4][2], const Unit& u, int wr, int wc, int fr, int fq) const {
        const int row0 = u.pm * 256 + wr * 64 + fr, col0 = u.pn * 256 + wc * 32 + 8 * fq;
#pragma unroll
        for (int ai = 0; ai < 2; ++ai)
#pragma unroll
            for (int m = 0; m < 4; ++m) {
                const int row = row0 + ai * 128 + m * 16;
                const float mu = stat[2 * row], rs = stat[2 * row + 1];
#pragma unroll
                for (int bj = 0; bj < 2; ++bj) {
                    const int c0 = col0 + bj * 128;
                    const size_t o = (size_t)row * DM + c0;
                    const u32x4 zw = *(const u32x4*)(zin + o);
                    const f32x4 g0 = *(const f32x4*)(g + c0), g1 = *(const f32x4*)(g + c0 + 4), b0 = *(const f32x4*)(b + c0), b1 = *(const f32x4*)(b + c0 + 4);
                    const f32x4 z0 = (f32x4){bflo(zw.x), bfhi(zw.x), bflo(zw.y), bfhi(zw.y)}, z1 = (f32x4){bflo(zw.z), bfhi(zw.z), bflo(zw.w), bfhi(zw.w)};
                    const f32x4 h0 = (z0 - mu) * rs * g0 + b0, h1 = (z1 - mu) * rs * g1 + b1;
                    const f32x4 r0 = h0 * ALPHA + acc[ai][bj][m][0] * sc, r1 = h1 * ALPHA + acc[ai][bj][m][1] * sc;
                    u32x4 w; w.x = cvt_pk_bf16(r0[0], r0[1]); w.y = cvt_pk_bf16(r0[2], r0[3]); w.z = cvt_pk_bf16(r1[0], r1[1]); w.w = cvt_pk_bf16(r1[2], r1[3]);
                    __builtin_nontemporal_store(w, (u32x4*)(zout + o));
                }
            }
    }
};

struct EpiLoraAll {
    static constexpr bool PERM = true;
    unsigned short* O; const float* w0; const float* a0;
    __device__ __forceinline__ void operator()(const f32x4 (&acc)[2][2][4][2], const Unit& u, int wr, int wc, int fr, int fq) const {
        const int kind = u.pn >> 1;
        Unit v; v.pm = u.pm; v.pn = u.pn & 1;
        if (kind == 0) { EpiLora<0> e{O, w0}; e(acc, v, wr, wc, fr, fq); }
        else if (kind == 1) { EpiLora<1> e{O + 512, a0}; e(acc, v, wr, wc, fr, fq); }
        else { EpiLora<2> e{O + 1024, nullptr}; e(acc, v, wr, wc, fr, fq); }
    }
};
template <class F>
__device__ __forceinline__ void cvt_job(int wsg, LAS unsigned char* lds, bf16_t* dst, int Np, int Kp, F f) {
    const int tid = otid(wsg);
    const int ntn = Np / 64, ntk = Kp / 64, ntiles = ntn * ntk;
    LAS bf16_t* T = (LAS bf16_t*)lds;
    for (int t = blockIdx.x; t < ntiles; t += gridDim.x) {
        const int n0 = (t % ntn) * 64, k0 = (t / ntn) * 64;
        __syncthreads();
#pragma unroll
        for (int i = 0; i < 8; ++i) {
            const int n = tid & 63, k = (tid >> 6) + 8 * i;
            const float v = f(n0 + n, k0 + k);
            T[n * 66 + k] = (bf16_t)(cvt_pk_bf16(v, 0.f) & 0xffffu);
        }
        __syncthreads();
        {
            const int n = tid >> 3, ks = (tid & 7) * 8;
            const LAS unsigned* rp = (const LAS unsigned*)(T + n * 66 + ks);
            u32x4 w; w.x = rp[0]; w.y = rp[1]; w.z = rp[2]; w.w = rp[3];
            *(u32x4*)(dst + (size_t)(n0 + n) * Kp + k0 + ks) = w;
        }
    }
}

__device__ void prologue_phase(int wsg, LAS unsigned char* lds, const Params& p) {
    unsigned char* ws = p.ws;
#pragma unroll 1
    for (int f = 0; f < 2; ++f) {
        const float* w1 = p.in[f ? I_F2W1 : I_F1W1]; const float* w3 = p.in[f ? I_F2W3 : I_F1W3]; const float* w2 = p.in[f ? I_F2W2 : I_F1W2];
        cvt_job(wsg, lds, (bf16_t*)(ws + (f ? OFF_W13_2 : OFF_W13_1)), NFF1, DM, [=](int n, int k) -> float {
            const int pn = n >> 8, half = (n >> 7) & 1, c = pn * 128 + (n & 127);
            return c < DFF ? (half ? w3[(size_t)k * DFF + c] * 0.6931471805599453f : w1[(size_t)k * DFF + c] * 1.4426950408889634f) : 0.f; });
        cvt_job(wsg, lds, (bf16_t*)(ws + (f ? OFF_W2_2 : OFF_W2_1)), DM, DFFP, [=](int n, int k) -> float { return k < DFF ? w2[(size_t)k * DM + n] : 0.f; });
    }
    {
        const float* w = p.in[I_WIN];
        cvt_job(wsg, lds, (bf16_t*)(ws + OFF_WIN), 4608, DM, [=](int n, int k) -> float {
            const int c = n < 2496 ? n : (n < 2560 ? -1 : n - 64);
            return c < 0 ? 0.f : w[(size_t)k * IN_COLS + c] * (n >= 2560 ? 1.4426950408889634f : 1.0f); });
    }
    {
        const float* wd = p.in[I_WDU]; const float* wi = p.in[I_WIU]; const float* wg = p.in[I_WGU];
        cvt_job(wsg, lds, (bf16_t*)(ws + OFF_WLORA), 1536, 384, [=](int n, int k) -> float {
            if (n < 512) return k < 64 ? wd[k * 512 + n] : 0.f;
            if (n < 1024) return (k >= 64 && k < 128) ? wi[(k - 64) * 512 + (n - 512)] : 0.f;
            return (k >= 128 && k < 288) ? wg[(k - 128) * 512 + (n - 1024)] : 0.f; });
    }
    {
        const float* w = p.in[I_WQU];
        cvt_job(wsg, lds, (bf16_t*)(ws + OFF_WQ), 768, 384, [=](int n, int k) -> float {
            const int hd = n / 96, s = n % 96; int o = s;
            if (s >= 64) { const int pp = s - 64, i = pp >> 1; o = 64 + ((pp & 1) ? i + 16 : i); }
            return w[k * 768 + hd * 96 + o]; });
    }
    { const float* w = p.in[I_WKVU]; cvt_job(wsg, lds, (bf16_t*)(ws + OFF_WKV), 1024, 256, [=](int n, int k) -> float { return w[k * 1024 + n]; }); }
    { const float* w = p.in[I_WUR]; cvt_job(wsg, lds, (bf16_t*)(ws + OFF_WUR), 1024, 512, [=](int n, int k) -> float { return w[k * 1024 + n]; }); }
    { const float* w = p.in[I_WUM]; cvt_job(wsg, lds, (bf16_t*)(ws + OFF_WUM), 1024, 512, [=](int n, int k) -> float { return w[k * 1024 + n]; }); }
    { const float* w = p.in[I_WO]; cvt_job(wsg, lds, (bf16_t*)(ws + OFF_WO), 1024, 1024, [=](int n, int k) -> float { return w[k * 1024 + n]; }); }
    {
        float* rc = (float*)(ws + OFF_ROPE);
        const int gstride = gridDim.x * 512;
        for (int i = blockIdx.x * 512 + otid(wsg); i < 8192 * 16; i += gstride) {
            const int pos = i >> 4, f = i & 15;
            const float inv = powf(10000.0f, -(float)f * (1.0f / 16.0f));
            const float ang = (float)pos * inv;
            rc[i] = cosf(ang); rc[8192 * 16 + i] = sinf(ang);
        }
    }
    {
        const float* x = p.in[I_X]; bf16_t* xb = (bf16_t*)(ws + OFF_R1);
        const long total = (long)T_TOK * DM / 8, gstride = (long)gridDim.x * 512;
        for (long i = (long)blockIdx.x * 512 + otid(wsg); i < total; i += gstride) {
            const f32x4 a = __builtin_nontemporal_load((const f32x4*)(x + i * 8)), b = __builtin_nontemporal_load((const f32x4*)(x + i * 8 + 4));
            u32x4 w; w.x = cvt_pk_bf16(a[0], a[1]); w.y = cvt_pk_bf16(a[2], a[3]); w.z = cvt_pk_bf16(b[0], b[1]); w.w = cvt_pk_bf16(b[2], b[3]);
            *(u32x4*)(xb + i * 8) = w;
        }
    }
}

__device__ void ln_phase(int wsg, float* io, const float* g, const float* b, bf16_t* ob, float pre) {
    const int t_ = otid(wsg); const int lane = t_ & 63, wv = blockIdx.x * 8 + (t_ >> 6), nw = gridDim.x * 8;
    f32x4 gv[4], bv[4];
#pragma unroll
    for (int i = 0; i < 4; ++i) { gv[i] = *(const f32x4*)(g + i * 256 + lane * 4); bv[i] = *(const f32x4*)(b + i * 256 + lane * 4); }
    for (int row = wv; row < T_TOK; row += nw) {
        float* rp = io + (size_t)row * DM + lane * 4;
        f32x4 v[4]; float s = 0.f;
#pragma unroll
        for (int i = 0; i < 4; ++i) { v[i] = *(const f32x4*)(rp + i * 256) * pre; s += v[i][0] + v[i][1] + v[i][2] + v[i][3]; }
#pragma unroll
        for (int o = 32; o > 0; o >>= 1) s += shx(s, lane, o);
        const float mu = s * (1.0f / DM);
        float q = 0.f;
#pragma unroll
        for (int i = 0; i < 4; ++i) { v[i] = v[i] - mu; q += v[i][0] * v[i][0] + v[i][1] * v[i][1] + v[i][2] * v[i][2] + v[i][3] * v[i][3]; }
#pragma unroll
        for (int o = 32; o > 0; o >>= 1) q += shx(q, lane, o);
        const float rs = rsqrtf(q * (1.0f / DM) + 1e-5f);
#pragma unroll
        for (int i = 0; i < 4; ++i) {
            const f32x4 y = v[i] * rs * gv[i] + bv[i];
            *(f32x4*)(rp + i * 256) = y;
            if (ob) { u32x2 w; w.x = cvt_pk_bf16(y[0], y[1]); w.y = cvt_pk_bf16(y[2], y[3]); *(u32x2*)(ob + (size_t)row * DM + i * 256 + lane * 4) = w; }
        }
    }
}

__device__ void ln_stats_phase(int wsg, const float* zin, const float* g, const float* b, bf16_t* ob, float* stat) {
    const int t_ = otid(wsg); const int lane = t_ & 63, wv = blockIdx.x * 8 + (t_ >> 6), nw = gridDim.x * 8;
    f32x4 gv[4], bv[4];
#pragma unroll
    for (int i = 0; i < 4; ++i) { gv[i] = *(const f32x4*)(g + i * 256 + lane * 4); bv[i] = *(const f32x4*)(b + i * 256 + lane * 4); }
    for (int row = wv; row < T_TOK; row += nw) {
        const float* rp = zin + (size_t)row * DM + lane * 4;
        f32x4 v[4]; float s = 0.f;
#pragma unroll
        for (int i = 0; i < 4; ++i) { v[i] = *(const f32x4*)(rp + i * 256); s += v[i][0] + v[i][1] + v[i][2] + v[i][3]; }
#pragma unroll
        for (int o = 32; o > 0; o >>= 1) s += shx(s, lane, o);
        const float mu = s * (1.0f / DM);
        float q = 0.f;
#pragma unroll
        for (int i = 0; i < 4; ++i) { v[i] = v[i] - mu; q += v[i][0] * v[i][0] + v[i][1] * v[i][1] + v[i][2] * v[i][2] + v[i][3] * v[i][3]; }
#pragma unroll
        for (int o = 32; o > 0; o >>= 1) q += shx(q, lane, o);
        const float rs = rsqrtf(q * (1.0f / DM) + 1e-5f);
        if (lane == 0) { stat[2 * row] = mu; stat[2 * row + 1] = rs; }
#pragma unroll
        for (int i = 0; i < 4; ++i) {
            const f32x4 y = v[i] * rs * gv[i] + bv[i];
            u32x2 w; w.x = cvt_pk_bf16(y[0], y[1]); w.y = cvt_pk_bf16(y[2], y[3]); *(u32x2*)(ob + (size_t)row * DM + i * 256 + lane * 4) = w;
        }
    }
}

__device__ void lnz_phase(int wsg, const bf16_t* zin, const float* g, const float* b, bf16_t* ob, float* of, float* stat) {
    const int t_ = otid(wsg); const int lane = t_ & 63, wv = blockIdx.x * 8 + (t_ >> 6), nw = gridDim.x * 8;
    f32x4 gv[4], bv[4];
#pragma unroll
    for (int i = 0; i < 4; ++i) { gv[i] = *(const f32x4*)(g + i * 256 + lane * 4); bv[i] = *(const f32x4*)(b + i * 256 + lane * 4); }
    for (int row = wv; row < T_TOK; row += nw) {
        const bf16_t* rp = zin + (size_t)row * DM + lane * 4;
        f32x4 v[4]; float s = 0.f;
#pragma unroll
        for (int i = 0; i < 4; ++i) { const u32x2 w = *(const u32x2*)(rp + i * 256); v[i] = (f32x4){bflo(w.x), bfhi(w.x), bflo(w.y), bfhi(w.y)}; s += v[i][0] + v[i][1] + v[i][2] + v[i][3]; }
#pragma unroll
        for (int o = 32; o > 0; o >>= 1) s += shx(s, lane, o);
        const float mu = s * (1.0f / DM);
        float q = 0.f;
#pragma unroll
        for (int i = 0; i < 4; ++i) { v[i] = v[i] - mu; q += v[i][0] * v[i][0] + v[i][1] * v[i][1] + v[i][2] * v[i][2] + v[i][3] * v[i][3]; }
#pragma unroll
        for (int o = 32; o > 0; o >>= 1) q += shx(q, lane, o);
        const float rs = rsqrtf(q * (1.0f / DM) + 1e-5f);
        if (stat && lane == 0) { stat[2 * row] = mu; stat[2 * row + 1] = rs; }
#pragma unroll
        for (int i = 0; i < 4; ++i) {
            const f32x4 y = v[i] * rs * gv[i] + bv[i];
            if (of) __builtin_nontemporal_store(y, (f32x4*)(of + (size_t)row * DM + i * 256 + lane * 4));
            if (ob) { u32x2 w; w.x = cvt_pk_bf16(y[0], y[1]); w.y = cvt_pk_bf16(y[2], y[3]); *(u32x2*)(ob + (size_t)row * DM + i * 256 + lane * 4) = w; }
        }
    }
}

__device__ void f32_to_bf16_phase(int wsg, const float* src, bf16_t* dst, long n8) {
    const long gstride = (long)gridDim.x * 512;
    for (long i = (long)blockIdx.x * 512 + otid(wsg); i < n8; i += gstride) {
        const f32x4 a = *(const f32x4*)(src + i * 8), b = *(const f32x4*)(src + i * 8 + 4);
        u32x4 w; w.x = cvt_pk_bf16(a[0], a[1]); w.y = cvt_pk_bf16(a[2], a[3]); w.z = cvt_pk_bf16(b[0], b[1]); w.w = cvt_pk_bf16(b[2], b[3]);
        *(u32x4*)(dst + i * 8) = w;
    }
}

__device__ __forceinline__ float wave_sum(float s, int lane) {
#pragma unroll
    for (int o = 32; o > 0; o >>= 1) s += shx(s, lane, o);
    return s;
}
__device__ __forceinline__ void unpack4(u32x2 w, float (&x)[4]) { x[0] = bflo(w.x); x[1] = bfhi(w.x); x[2] = bflo(w.y); x[3] = bfhi(w.y); }
__device__ __forceinline__ u32x2 pack4(const float (&x)[4]) { u32x2 w; w.x = cvt_pk_bf16(x[0], x[1]); w.y = cvt_pk_bf16(x[2], x[3]); return w; }

__device__ void prep_phase(int wsg, const Params& p) {
    unsigned char* ws = p.ws;
    const bf16_t* __restrict__ PROJ = (const bf16_t*)(ws + OFF_R3);
    bf16_t* __restrict__ LIN = (bf16_t*)(ws + OFF_R1); bf16_t* __restrict__ QN = (bf16_t*)(ws + OFF_R1 + 48 * MiB); bf16_t* __restrict__ KVN = (bf16_t*)(ws + OFF_R1 + 96 * MiB);
    bf16_t* __restrict__ KPE = (bf16_t*)(ws + OFF_R4 + 128 * MiB);
    const float* mu = p.in[I_MU]; const float* qg = p.in[I_QNG]; const float* kvg = p.in[I_KVNG]; const float* rope = (const float*)(ws + OFF_ROPE);
    const int t_ = otid(wsg); const int lane = t_ & 63, wv = blockIdx.x * 8 + (t_ >> 6), nw = gridDim.x * 8;
#pragma unroll 2
    for (int row = wv; row < T_TOK; row += nw) {
        const bf16_t* P = PROJ + (size_t)row * PROJ_LD; const int pos = row & (SEQ - 1); const bool hp = pos != 0; const bf16_t* Pp = P - PROJ_LD;
#pragma unroll
        for (int it = 0; it < 2; ++it) {
            const int idx = it * 256 + lane * 4;
            if (idx < 288) {
                float c[4], pv[4] = {0.f, 0.f, 0.f, 0.f}; unpack4(*(const u32x2*)(P + 1536 + idx), c);
                if (hp) unpack4(*(const u32x2*)(Pp + 1536 + idx), pv);
                const f32x4 m4 = *(const f32x4*)(mu + 1536 + idx);
                float o[4];
#pragma unroll
                for (int e = 0; e < 4; ++e) { const float x = c[e] + m4[e] * (pv[e] - c[e]); o[e] = idx < 64 ? tanhf(x) : (idx < 128 ? x : __builtin_amdgcn_rcpf(1.0f + __expf(-x))); }
                *(u32x2*)(LIN + (size_t)row * 384 + idx) = pack4(o);
            } else if (idx < 384) { u32x2 z; z.x = 0u; z.y = 0u; *(u32x2*)(LIN + (size_t)row * 384 + idx) = z; }
        }
        {
            float a[4], b[4] = {0.f, 0.f, 0.f, 0.f}; unpack4(*(const u32x2*)(P + 1824 + lane * 4), a);
            if (lane < 32) unpack4(*(const u32x2*)(P + 1824 + 256 + lane * 4), b);
            float ss = a[0] * a[0] + a[1] * a[1] + a[2] * a[2] + a[3] * a[3] + b[0] * b[0] + b[1] * b[1] + b[2] * b[2] + b[3] * b[3];
            ss = wave_sum(ss, lane);
            const float r = rsqrtf(ss * (1.0f / 384.0f) + 1e-6f);
            const f32x4 g0 = *(const f32x4*)(qg + lane * 4);
            float o[4];
#pragma unroll
            for (int e = 0; e < 4; ++e) o[e] = a[e] * r * g0[e];
            *(u32x2*)(QN + (size_t)row * 384 + lane * 4) = pack4(o);
            if (lane < 32) { const f32x4 g1 = *(const f32x4*)(qg + 256 + lane * 4);
#pragma unroll
                for (int e = 0; e < 4; ++e) o[e] = b[e] * r * g1[e];
                *(u32x2*)(QN + (size_t)row * 384 + 256 + lane * 4) = pack4(o); }
        }
        {
            float a[4]; unpack4(*(const u32x2*)(P + 2208 + lane * 4), a);
            float ss = a[0] * a[0] + a[1] * a[1] + a[2] * a[2] + a[3] * a[3];
            ss = wave_sum(ss, lane);
            const float r = rsqrtf(ss * (1.0f / 256.0f) + 1e-6f);
            const f32x4 g0 = *(const f32x4*)(kvg + lane * 4);
            float o[4];
#pragma unroll
            for (int e = 0; e < 4; ++e) o[e] = a[e] * r * g0[e];
            *(u32x2*)(KVN + (size_t)row * 256 + lane * 4) = pack4(o);
        }
        if (lane < 16) {
            const float x1 = bf2f(P[2464 + lane]), x2 = bf2f(P[2464 + 16 + lane]);
            const float cs = rope[pos * 16 + lane], sn = rope[8192 * 16 + pos * 16 + lane];
            *(unsigned*)(KPE + (size_t)row * 32 + 2 * lane) = cvt_pk_bf16(x1 * cs - x2 * sn, x2 * cs + x1 * sn);
        }
    }
}

__device__ void attn_phase(int wsg, LAS unsigned char* lds, const bf16_t* Q, const bf16_t* KN, const bf16_t* KPE, const bf16_t* VT, bf16_t* YM, unsigned* counter, const float* rope) {
    constexpr int KSTR = 208, VSTR = 136, KBUF = 64 * KSTR, VBUF = 64 * VSTR, V_OFF0 = 2 * KBUF, ITEM_OFF = V_OFF0 + 3 * VBUF;
    const int tid_ = otid(wsg);
    const int tid = tid_, lane = tid & 63, wid = tid >> 6, l31 = lane & 31, half = lane >> 5;
    volatile LAS int* s_item = (volatile LAS int*)(lds + ITEM_OFF);
    const int xcd = (int)(__builtin_amdgcn_s_getreg((3 << 11) | 20) & 7u);
    for (;;) {
        __syncthreads();
        if (tid == 0) {
            int it = -1;
            for (int s = 0; s < 8 && it < 0; ++s) { const int q = (xcd + s) & 7; const unsigned i = atomicAdd(counter + q * 16, 1u); if (i < 256u) it = q * 256 + (int)i; }
            *s_item = it;
        }
        __syncthreads();
        const int item = *s_item;
        if (item < 0) break;
        const int qi = item & 255, bh = (item >> 8) + 8 * (qi & 7), qb = 31 - (qi >> 3), b = bh >> 3, h = bh & 7;
        const size_t tb = (size_t)b * SEQ;
        const int qrow = qb * 256 + wid * 32 + l31;
        bf16x8 qf[6];
#pragma unroll
        for (int ks = 0; ks < 6; ++ks) qf[ks] = *(const bf16x8*)(Q + (tb + qrow) * 768 + h * 96 + ks * 16 + half * 8);
#pragma unroll
        for (int ks = 4; ks < 6; ++ks) {
            const int p0 = (ks - 4) * 8 + half * 4;
            const f32x4 cs = *(const f32x4*)(rope + qrow * 16 + p0), sn = *(const f32x4*)(rope + 8192 * 16 + qrow * 16 + p0);
            const u32x4 w = __builtin_bit_cast(u32x4, qf[ks]);
            u32x4 o;
            { const float x1 = bflo(w.x), x2 = bfhi(w.x); o.x = cvt_pk_bf16(x1 * cs[0] - x2 * sn[0], x2 * cs[0] + x1 * sn[0]); }
            { const float x1 = bflo(w.y), x2 = bfhi(w.y); o.y = cvt_pk_bf16(x1 * cs[1] - x2 * sn[1], x2 * cs[1] + x1 * sn[1]); }
            { const float x1 = bflo(w.z), x2 = bfhi(w.z); o.z = cvt_pk_bf16(x1 * cs[2] - x2 * sn[2], x2 * cs[2] + x1 * sn[2]); }
            { const float x1 = bflo(w.w), x2 = bfhi(w.w); o.w = cvt_pk_bf16(x1 * cs[3] - x2 * sn[3], x2 * cs[3] + x1 * sn[3]); }
            qf[ks] = __builtin_bit_cast(bf16x8, o);
        }
        const int ntiles = 4 * qb + 4, jmax = 4 * qb + (wid >> 1);
        const int skey = tid >> 3, sseg = tid & 7;
        const bf16_t* gK = KN + (tb + skey) * 512 + h * 64 + sseg * 8;
        const bf16_t* gP = KPE + (tb + ((tid & 255) >> 2)) * 32 + (tid & 3) * 8;
        const bf16_t* gV = VT + ((size_t)((b * 8 + h) * 64 + skey)) * SEQ + sseg * 8;
        const unsigned lK = skey * KSTR + sseg * 16, lP = (tid >> 2) * KSTR + 128 + (tid & 3) * 16, lV = V_OFF0 + skey * VSTR + sseg * 16;
        u32x4 rK = *(const u32x4*)gK, rP = (u32x4){0u, 0u, 0u, 0u}, rV = *(const u32x4*)gV;
        rP = *(const u32x4*)gP;
        *(LAS u32x4*)(lds + lK) = rK; if (tid < 256) *(LAS u32x4*)(lds + lP) = rP; *(LAS u32x2*)(lds + lV) = (u32x2){rV.x, rV.y}; *(LAS u32x2*)(lds + lV + 8) = (u32x2){rV.z, rV.w};
        rK = *(const u32x4*)(gK + (size_t)64 * 512); rV = *(const u32x4*)(gV + 64); rP = *(const u32x4*)(gP + (size_t)64 * 32);
        u32x4 nK = rK, nP = rP, nV = rV;
        __syncthreads();
        f32x16 ot[2], st[2];
#pragma unroll
        for (int i = 0; i < 16; ++i) { ot[0][i] = 0.f; ot[1][i] = 0.f; st[0][i] = 0.f; st[1][i] = 0.f; }
        float mrun = 0.f, lrun = 0.f;
        auto QK = [&](int jt) {
            const float negm = -mrun;
#pragma unroll
            for (int i = 0; i < 16; ++i) { st[0][i] = negm; st[1][i] = negm; }
            const LAS unsigned char* kb = lds + (jt & 1) * KBUF + l31 * KSTR + half * 16;
#pragma unroll
            for (int ks = 0; ks < 6; ++ks)
#pragma unroll
                for (int kt = 0; kt < 2; ++kt) {
                    const bf16x8 a = *(const LAS bf16x8*)(kb + kt * 32 * KSTR + ks * 32);
                    st[kt] = __builtin_amdgcn_mfma_f32_32x32x16_bf16(a, qf[ks], st[kt], 0, 0, 0);
                }
        };
        auto SMPV = [&](int jt) {
            float mx = fmaxf(st[0][0], st[1][0]);
#pragma unroll
            for (int i = 1; i < 16; ++i) mx = fmaxf(fmaxf(mx, st[0][i]), st[1][i]);
            mx = fmaxf(mx, shx(mx, lane, 32));
            const bool slow = (jt == 0) || (__builtin_amdgcn_ballot_w64(mx > 8.0f) != 0ull);
            if (slow) {
                const float delta = (jt == 0 || mx > 0.f) ? mx : 0.f;
                const float alpha = __builtin_amdgcn_exp2f(-delta);
                mrun += delta; lrun *= alpha;
#pragma unroll
                for (int i = 0; i < 16; ++i) { ot[0][i] *= alpha; ot[1][i] *= alpha; st[0][i] -= delta; st[1][i] -= delta; }
            }
            float rs = 0.f;
#pragma unroll
            for (int kt = 0; kt < 2; ++kt)
#pragma unroll
                for (int i = 0; i < 16; ++i) { const float pe = __builtin_amdgcn_exp2f(st[kt][i]); st[kt][i] = pe; rs += pe; }
            lrun += rs;
            bf16x8 pf[2][2];
#pragma unroll
            for (int kt = 0; kt < 2; ++kt)
#pragma unroll
                for (int s2 = 0; s2 < 2; ++s2) {
                    u32x4 w; w.x = cvt_pk_bf16(st[kt][8 * s2 + 0], st[kt][8 * s2 + 1]); w.y = cvt_pk_bf16(st[kt][8 * s2 + 2], st[kt][8 * s2 + 3]);
                    w.z = cvt_pk_bf16(st[kt][8 * s2 + 4], st[kt][8 * s2 + 5]); w.w = cvt_pk_bf16(st[kt][8 * s2 + 6], st[kt][8 * s2 + 7]);
                    pf[kt][s2] = __builtin_bit_cast(bf16x8, w);
                }
            __builtin_amdgcn_sched_barrier(0);
            const LAS unsigned char* vb = lds + V_OFF0 + (jt % 3) * VBUF + l31 * VSTR + half * 8;
#pragma unroll
            for (int dvt = 0; dvt < 2; ++dvt)
#pragma unroll
                for (int kt = 0; kt < 2; ++kt)
#pragma unroll
                    for (int s2 = 0; s2 < 2; ++s2) {
                        const LAS unsigned char* vp = vb + dvt * 32 * VSTR + (kt * 32 + s2 * 16) * 2;
                        const u32x2 lo = *(const LAS u32x2*)vp, hi = *(const LAS u32x2*)(vp + 16);
                        u32x4 av; av.x = lo.x; av.y = lo.y; av.z = hi.x; av.w = hi.y;
                        ot[dvt] = __builtin_amdgcn_mfma_f32_32x32x16_bf16(__builtin_bit_cast(bf16x8, av), pf[kt][s2], ot[dvt], 0, 0, 0);
                    }
        };
        const bool late = wid >= 4;
        if (late) __builtin_amdgcn_s_setprio(1);
        auto step = [&](int j, u32x4& aK, u32x4& aP, u32x4& aV, u32x4& bK, u32x4& bP, u32x4& bV) {
            if (j + 2 < ntiles) {
                bK = *(const u32x4*)(gK + (size_t)(j + 2) * 64 * 512); bV = *(const u32x4*)(gV + (j + 2) * 64); bP = *(const u32x4*)(gP + (size_t)(j + 2) * 64 * 32);
            }
            if (!late) {
                if (j < ntiles && j <= jmax) { QK(j); __builtin_amdgcn_sched_barrier(0); SMPV(j); }
            } else {
                if (j >= 1 && j - 1 <= jmax) SMPV(j - 1);
                __builtin_amdgcn_sched_barrier(0);
                if (j < ntiles && j <= jmax) QK(j);
            }
            if (j + 1 < ntiles) {
                const unsigned kofs = (unsigned)((j + 1) & 1) * KBUF, vofs = (unsigned)((j + 1) % 3) * VBUF;
                *(LAS u32x4*)(lds + kofs + lK) = aK; if (tid < 256) *(LAS u32x4*)(lds + kofs + lP) = aP; *(LAS u32x2*)(lds + vofs + lV) = (u32x2){aV.x, aV.y}; *(LAS u32x2*)(lds + vofs + lV + 8) = (u32x2){aV.z, aV.w};
            }
            __syncthreads();
        };
        for (int j = 0; j <= ntiles; j += 2) {
            step(j, rK, rP, rV, nK, nP, nV);
            if (j + 1 <= ntiles) step(j + 1, nK, nP, nV, rK, rP, rV);
        }
        __builtin_amdgcn_s_setprio(0);
        lrun += shx(lrun, lane, 32);
        const float inv = 1.0f / lrun;
        bf16_t* op = YM + (tb + qrow) * 512 + h * 64 + half * 4;
#pragma unroll
        for (int dvt = 0; dvt < 2; ++dvt)
#pragma unroll
            for (int g = 0; g < 4; ++g) {
                u32x2 w; w.x = cvt_pk_bf16(ot[dvt][4 * g] * inv, ot[dvt][4 * g + 1] * inv); w.y = cvt_pk_bf16(ot[dvt][4 * g + 2] * inv, ot[dvt][4 * g + 3] * inv);
                *(u32x2*)(op + dvt * 32 + g * 8) = w;
            }
    }
}

constexpr int MS = 144;
constexpr int MB = 64 * MS;
constexpr int SC_KT = 0, SC_BT = MB, SC_QK = 2 * MB, SC_RT = 3 * MB, SC_KH = 4 * MB, SC_BH = 5 * MB, SC_VM = 6 * MB, SC_S0 = 7 * MB,
              SC_MK = 8 * MB, SC_AK = 9 * MB, SC_AB = 10 * MB, SC_RHS = 11 * MB, SC_NT = 12 * MB  , SC_MISC = SC_NT + 64 * 68 * 4;
constexpr int SC_TT = SC_KT, SC_UN = SC_MK, SC_YF = SC_NT;
constexpr int SS = 80;
constexpr int SC_N12 = SC_BT, SC_XT = SC_BT + 32 * SS, SC_T11 = SC_BT + 64 * SS;
static_assert(SC_MISC + 1024 <= LDS_MAIN, "scan LDS overflow");

template <int KS, bool SWA = false, bool SWB = false>
__device__ __forceinline__ f32x16 mm_tile(f32x16 acc, const LAS unsigned char* A, int arow0, const LAS unsigned char* B, int brow0, int l31, int half) {
    const int ra = arow0 + l31, rb = brow0 + l31;
    const LAS unsigned char* ap = A + ra * MS;
    const LAS unsigned char* bp = B + rb * MS;
    const int sa = SWA ? ((ra >> 3) & 7) : 0, sb = SWB ? ((rb >> 3) & 7) : 0;
#pragma unroll
    for (int ks = 0; ks < KS; ++ks) {
        const int q = ks * 2 + half;
        acc = __builtin_amdgcn_mfma_f32_32x32x16_bf16(*(const LAS bf16x8*)(ap + ((q ^ sa) << 4)), *(const LAS bf16x8*)(bp + ((q ^ sb) << 4)), acc, 0, 0, 0);
    }
    return acc;
}
__device__ __forceinline__ void store_tile_nm(LAS unsigned char* D, int nrow0, int mcol0, const f32x16& acc, int l31, int half, float sc, int stride = MS) {
    LAS unsigned char* dp = D + (nrow0 + l31) * stride + (mcol0 + half * 4) * 2;
#pragma unroll
    for (int g = 0; g < 4; ++g) { u32x2 w; w.x = cvt_pk_bf16(acc[4 * g] * sc, acc[4 * g + 1] * sc); w.y = cvt_pk_bf16(acc[4 * g + 2] * sc, acc[4 * g + 3] * sc); *(LAS u32x2*)(dp + g * 16) = w; }
}
__device__ __forceinline__ f32x16 zero16() { f32x16 z;
#pragma unroll
    for (int i = 0; i < 16; ++i) z[i] = 0.f; return z; }

__device__ void scan_chain(int wsg, LAS unsigned char* lds, const Params& p, int chain) {
    unsigned char* ws = p.ws;
    const bf16_t* PROJ = (const bf16_t*)(ws + OFF_R3);
    const unsigned short* WAG = (const unsigned short*)(ws + OFF_R2);
    bf16_t* YR = (bf16_t*)(ws + OFF_R1);
    const int tid0 = otid(wsg), wid = __builtin_amdgcn_readfirstlane(tid0 >> 6);
    const int b = chain >> 3, h = chain & 7;
    for (int i = tid0; i < MB / 4; i += 512) *(LAS unsigned*)(lds + SC_S0 + i * 4) = 0u;
    f32x16 st = zero16();
    const size_t tok0 = (size_t)b * SEQ;
    u32x4 cr, ck, cv, pr, pk, pv, ce, ca, cg;
    auto prefetch = [&](int c, int tl, int hc) {
        const size_t tok = tok0 + (size_t)c * 64 + tl;
        const bf16_t* P = PROJ + tok * PROJ_LD + hc;
        cr = *(const u32x4*)P; ck = *(const u32x4*)(P + 512); cv = *(const u32x4*)(P + 1024);
        if (c * 64 + tl > 0) { pr = *(const u32x4*)(P - PROJ_LD); pk = *(const u32x4*)(P - PROJ_LD + 512); pv = *(const u32x4*)(P - PROJ_LD + 1024); }
        else { pr = (u32x4){0u, 0u, 0u, 0u}; pk = pr; pv = pr; }
        const unsigned short* W = WAG + tok * 1536 + hc;
        ce = *(const u32x4*)W; ca = *(const u32x4*)(W + 512); cg = *(const u32x4*)(W + 1024);
    };
    prefetch(0, tid0 >> 3, h * 64 + (tid0 & 7) * 8);
    LAS float* NT = (LAS float*)(lds + SC_NT);
    LAS float* WC = (LAS float*)(lds + SC_MISC);
#pragma unroll 1
    for (int c = 0; c < SEQ / 64; ++c) {
        int tid = tid0; asm volatile("" : "+v"(tid));
        const int lane = tid & 63, l31 = lane & 31, half = lane >> 5;
        const int tl = tid >> 3, kseg = tid & 7, k0 = kseg * 8, hc = h * 64 + k0;
        float r_[8], k_[8], v_[8], e_[8], a_[8], g_[8];
        {
            float mu_r[8], mu_k[8], mu_v[8];
            { const f32x4 a0 = *(const f32x4*)(p.in[I_MU] + hc), a1 = *(const f32x4*)(p.in[I_MU] + hc + 4), b0 = *(const f32x4*)(p.in[I_MU] + 512 + hc), b1 = *(const f32x4*)(p.in[I_MU] + 512 + hc + 4),
                          c0 = *(const f32x4*)(p.in[I_MU] + 1024 + hc), c1 = *(const f32x4*)(p.in[I_MU] + 1024 + hc + 4);
#pragma unroll
              for (int e = 0; e < 4; ++e) { mu_r[e] = a0[e]; mu_r[4 + e] = a1[e]; mu_k[e] = b0[e]; mu_k[4 + e] = b1[e]; mu_v[e] = c0[e]; mu_v[4 + e] = c1[e]; } }
            const unsigned wr_[4] = {cr.x, cr.y, cr.z, cr.w}, wk_[4] = {ck.x, ck.y, ck.z, ck.w}, wv_[4] = {cv.x, cv.y, cv.z, cv.w};
            const unsigned xr_[4] = {pr.x, pr.y, pr.z, pr.w}, xk_[4] = {pk.x, pk.y, pk.z, pk.w}, xv_[4] = {pv.x, pv.y, pv.z, pv.w};
            const unsigned we_[4] = {ce.x, ce.y, ce.z, ce.w}, wa_[4] = {ca.x, ca.y, ca.z, ca.w}, wg_[4] = {cg.x, cg.y, cg.z, cg.w};
#pragma unroll
            for (int q = 0; q < 4; ++q) {
                float c0 = bflo(wr_[q]), c1 = bfhi(wr_[q]); r_[2 * q] = c0 + mu_r[2 * q] * (bflo(xr_[q]) - c0); r_[2 * q + 1] = c1 + mu_r[2 * q + 1] * (bfhi(xr_[q]) - c1);
                c0 = bflo(wk_[q]); c1 = bfhi(wk_[q]); k_[2 * q] = c0 + mu_k[2 * q] * (bflo(xk_[q]) - c0); k_[2 * q + 1] = c1 + mu_k[2 * q + 1] * (bfhi(xk_[q]) - c1);
                c0 = bflo(wv_[q]); c1 = bfhi(wv_[q]); v_[2 * q] = c0 + mu_v[2 * q] * (bflo(xv_[q]) - c0); v_[2 * q + 1] = c1 + mu_v[2 * q + 1] * (bfhi(xv_[q]) - c1);
                e_[2 * q] = f16lo(we_[q]); e_[2 * q + 1] = f16hi(we_[q]); a_[2 * q] = f16lo(wa_[q]); a_[2 * q + 1] = f16hi(wa_[q]); g_[2 * q] = f16lo(wg_[q]); g_[2 * q + 1] = f16hi(wg_[q]);
            }
        }
        if (c + 1 < SEQ / 64) prefetch(c + 1, tl, hc);
        float kk_[8], bb_[8], bonus = 0.f;
        {
            float kkc[8], kac[8], rkc[8];
            { const f32x4 a0 = *(const f32x4*)(p.in[I_KK] + hc), a1 = *(const f32x4*)(p.in[I_KK] + hc + 4), b0 = *(const f32x4*)(p.in[I_KA] + hc), b1 = *(const f32x4*)(p.in[I_KA] + hc + 4),
                          c0 = *(const f32x4*)(p.in[I_RK] + hc), c1 = *(const f32x4*)(p.in[I_RK] + hc + 4);
#pragma unroll
              for (int e = 0; e < 4; ++e) { kkc[e] = a0[e]; kkc[4 + e] = a1[e]; kac[e] = b0[e]; kac[4 + e] = b1[e]; rkc[e] = c0[e]; rkc[4 + e] = c1[e]; } }
            float ss = 0.f;
#pragma unroll
            for (int e = 0; e < 8; ++e) { kk_[e] = k_[e] * kkc[e]; ss += kk_[e] * kk_[e]; }
            ss += shx(ss, lane, 1); ss += shx(ss, lane, 2); ss += shx(ss, lane, 4);
            const float rn = rsqrtf(fmaxf(ss, 1e-24f));
#pragma unroll
            for (int e = 0; e < 8; ++e) { kk_[e] *= rn; k_[e] = k_[e] * (1.0f + (a_[e] - 1.0f) * kac[e]); bb_[e] = kk_[e] * a_[e]; bonus += r_[e] * k_[e] * rkc[e]; }
            bonus += shx(bonus, lane, 1); bonus += shx(bonus, lane, 2); bonus += shx(bonus, lane, 4);
        }
        float L[8], Lm[8], LC[8];
        {
#pragma unroll
            for (int e = 0; e < 8; ++e) L[e] = -e_[e];
            const int jj = lane >> 3;
#pragma unroll
            for (int d = 1; d < 8; d <<= 1) {
#pragma unroll
                for (int e = 0; e < 8; ++e) { const float y = __int_as_float(__builtin_amdgcn_ds_bpermute((lane - 8 * d) << 2, __float_as_int(L[e]))); L[e] += (jj >= d) ? y : 0.f; }
            }
            LAS float* TOT = (LAS float*)(lds + SC_RHS);
            if (jj == 7) { *(LAS f32x4*)(TOT + wid * 64 + k0) = (f32x4){L[0], L[1], L[2], L[3]}; *(LAS f32x4*)(TOT + wid * 64 + k0 + 4) = (f32x4){L[4], L[5], L[6], L[7]}; }
            __syncthreads();
            float off[8];
#pragma unroll
            for (int e = 0; e < 8; ++e) { off[e] = 0.f; LC[e] = 0.f; }
#pragma unroll
            for (int w = 0; w < 8; ++w) {
                const f32x4 t0 = *(const LAS f32x4*)(TOT + w * 64 + k0), t1 = *(const LAS f32x4*)(TOT + w * 64 + k0 + 4);
                const float tv[8] = {t0[0], t0[1], t0[2], t0[3], t1[0], t1[1], t1[2], t1[3]};
#pragma unroll
                for (int e = 0; e < 8; ++e) { LC[e] += tv[e]; off[e] += (w < wid) ? tv[e] : 0.f; }
            }
#pragma unroll
            for (int e = 0; e < 8; ++e) { L[e] += off[e]; Lm[e] = L[e] + e_[e]; }
            if (tl == 63) { *(LAS f32x4*)(WC + k0) = (f32x4){__expf(LC[0]), __expf(LC[1]), __expf(LC[2]), __expf(LC[3])}; *(LAS f32x4*)(WC + k0 + 4) = (f32x4){__expf(LC[4]), __expf(LC[5]), __expf(LC[6]), __expf(LC[7])}; }
        }
        {
            float qk[8], rt[8], kt[8], bt[8], kh[8], bh[8];
#pragma unroll
            for (int e = 0; e < 8; ++e) {
                const float el = __expf(L[e]), elm = __expf(Lm[e]), ei = __expf(-L[e]), ec = __expf(LC[e] - L[e]);
                qk[e] = kk_[e] * elm; rt[e] = r_[e] * el; kt[e] = k_[e] * ei; bt[e] = bb_[e] * ei; kh[e] = k_[e] * ec; bh[e] = bb_[e] * ec;
            }
            u32x4 w;
            w.x = cvt_pk_bf16(qk[0], qk[1]); w.y = cvt_pk_bf16(qk[2], qk[3]); w.z = cvt_pk_bf16(qk[4], qk[5]); w.w = cvt_pk_bf16(qk[6], qk[7]); *(LAS u32x4*)(lds + SC_QK + tl * MS + k0 * 2) = w;
            w.x = cvt_pk_bf16(rt[0], rt[1]); w.y = cvt_pk_bf16(rt[2], rt[3]); w.z = cvt_pk_bf16(rt[4], rt[5]); w.w = cvt_pk_bf16(rt[6], rt[7]); *(LAS u32x4*)(lds + SC_RT + tl * MS + k0 * 2) = w;
            w.x = cvt_pk_bf16(kt[0], kt[1]); w.y = cvt_pk_bf16(kt[2], kt[3]); w.z = cvt_pk_bf16(kt[4], kt[5]); w.w = cvt_pk_bf16(kt[6], kt[7]); *(LAS u32x4*)(lds + SC_KT + tl * MS + k0 * 2) = w;
            w.x = cvt_pk_bf16(bt[0], bt[1]); w.y = cvt_pk_bf16(bt[2], bt[3]); w.z = cvt_pk_bf16(bt[4], bt[5]); w.w = cvt_pk_bf16(bt[6], bt[7]); *(LAS u32x4*)(lds + SC_BT + tl * MS + k0 * 2) = w;
#pragma unroll
            for (int e = 0; e < 8; ++e) {
                const int toff = (k0 + e) * MS + ((wid ^ kseg) << 4) + (tl & 7) * 2;
                *(LAS bf16_t*)(lds + SC_KH + toff) = (bf16_t)(cvt_pk_bf16(kh[e], 0.f) & 0xffffu);
                *(LAS bf16_t*)(lds + SC_BH + toff) = (bf16_t)(cvt_pk_bf16(bh[e], 0.f) & 0xffffu);
                *(LAS bf16_t*)(lds + SC_VM + toff) = (bf16_t)(cvt_pk_bf16(v_[e], 0.f) & 0xffffu);
            }
        }
        __syncthreads();
#pragma unroll
        for (int q = 0; q < 2; ++q) {
            const int tile = wid * 2 + q, mi = tile >> 2, ni = tile & 3;
            const int ib = (mi & 1) * 32, tb = (ni & 1) * 32;
            if (ib > tb) {
                if (!(mi >= 2 && ni < 2)) { LAS unsigned char* D = lds + (mi < 2 ? (ni < 2 ? SC_MK : SC_AK) : SC_AB); store_tile_nm(D, tb, ib, zero16(), l31, half, 0.f); }
                else {
#pragma unroll
                    for (int i = 0; i < 16; ++i) NT[(tb + l31) * 68 + ib + 8 * (i >> 2) + 4 * half + (i & 3)] = 0.f; }
                continue;
            }
            f32x16 acc = mm_tile<4>(zero16(), lds + SC_KT, mi * 32, lds + SC_QK, ni * 32, l31, half);
            const bool strict = (ni < 2);
#pragma unroll
            for (int i = 0; i < 16; ++i) { const int ii = ib + 8 * (i >> 2) + 4 * half + (i & 3), tt = tb + l31; const bool keep = strict ? (ii < tt) : (ii <= tt); acc[i] = keep ? acc[i] : 0.f; }
            if (mi >= 2 && ni < 2) {
#pragma unroll
                for (int i = 0; i < 16; ++i) NT[(tb + l31) * 68 + ib + 8 * (i >> 2) + 4 * half + (i & 3)] = acc[i];
            } else { LAS unsigned char* D = lds + (mi < 2 ? (ni < 2 ? SC_MK : SC_AK) : SC_AB); store_tile_nm(D, tb, ib, acc, l31, half, 1.0f); }
        }
        __syncthreads();
        if (wid == 0) {
            const int base = half * 32;
            float Tj[32];
            f32x4 cur[8], nxt[8];
#pragma unroll
            for (int q = 0; q < 8; ++q) { cur[q] = (f32x4){0.f, 0.f, 0.f, 0.f}; nxt[q] = cur[q]; }
#pragma unroll
            for (int tt = 0; tt < 32; ++tt) {
                if (tt + 1 < 32) {
#pragma unroll
                    for (int i4 = 0; i4 < (tt + 1 + 3) / 4; ++i4) nxt[i4] = *(const LAS f32x4*)(NT + (base + tt + 1) * 68 + base + i4 * 4);
                }
                __builtin_amdgcn_sched_barrier(0);
                float s0 = (l31 == tt) ? 1.0f : 0.0f, s1 = 0.f;
#pragma unroll
                for (int ii = 0; ii < tt; ++ii) { if (ii & 1) s1 -= Tj[ii] * cur[ii >> 2][ii & 3]; else s0 -= Tj[ii] * cur[ii >> 2][ii & 3]; }
                Tj[tt] = s0 + s1;
                __builtin_amdgcn_sched_barrier(0);
#pragma unroll
                for (int q = 0; q < 8; ++q) cur[q] = nxt[q];
            }
#pragma unroll
            for (int tt = 0; tt < 32; ++tt) *(LAS bf16_t*)(lds + SC_TT + (base + tt) * MS + (base + l31) * 2) = (bf16_t)(cvt_pk_bf16(Tj[tt], 0.f) & 0xffffu);
            {
                LAS unsigned char* zp = lds + SC_TT + l31 * MS + 64 + half * 32;
                *(LAS u32x4*)zp = (u32x4){0u, 0u, 0u, 0u}; *(LAS u32x4*)(zp + 16) = (u32x4){0u, 0u, 0u, 0u};
            }
            if (half == 0) {
#pragma unroll
                for (int q = 0; q < 4; ++q) { u32x4 w; w.x = cvt_pk_bf16(Tj[8 * q], Tj[8 * q + 1]); w.y = cvt_pk_bf16(Tj[8 * q + 2], Tj[8 * q + 3]); w.z = cvt_pk_bf16(Tj[8 * q + 4], Tj[8 * q + 5]); w.w = cvt_pk_bf16(Tj[8 * q + 6], Tj[8 * q + 7]);
                    *(LAS u32x4*)(lds + SC_T11 + l31 * SS + q * 16) = w; }
            }
            {
                float nv[16];
#pragma unroll
                for (int s = 0; s < 16; ++s) nv[s] = NT[(32 + half * 16 + s) * 68 + l31];
                u32x4 w; w.x = cvt_pk_bf16(nv[0], nv[1]); w.y = cvt_pk_bf16(nv[2], nv[3]); w.z = cvt_pk_bf16(nv[4], nv[5]); w.w = cvt_pk_bf16(nv[6], nv[7]);
                *(LAS u32x4*)(lds + SC_N12 + l31 * SS + half * 32) = w;
                w.x = cvt_pk_bf16(nv[8], nv[9]); w.y = cvt_pk_bf16(nv[10], nv[11]); w.z = cvt_pk_bf16(nv[12], nv[13]); w.w = cvt_pk_bf16(nv[14], nv[15]);
                *(LAS u32x4*)(lds + SC_N12 + l31 * SS + half * 32 + 16) = w;
            }
            __builtin_amdgcn_fence(__ATOMIC_RELEASE, "workgroup"); __builtin_amdgcn_wave_barrier();
            {
                f32x16 x = zero16();
                const LAS unsigned char* ap = lds + SC_N12 + l31 * SS + half * 16;
                const LAS unsigned char* bp = lds + SC_TT + (32 + l31) * MS + (32 + half * 8) * 2;
#pragma unroll
                for (int ks = 0; ks < 2; ++ks) x = __builtin_amdgcn_mfma_f32_32x32x16_bf16(*(const LAS bf16x8*)(ap + ks * 32), *(const LAS bf16x8*)(bp + ks * 32), x, 0, 0, 0);
                store_tile_nm(lds + SC_XT, 0, 0, x, l31, half, 1.0f, SS);
            }
            __builtin_amdgcn_fence(__ATOMIC_RELEASE, "workgroup"); __builtin_amdgcn_wave_barrier();
            {
                f32x16 x = zero16();
                const LAS unsigned char* ap = lds + SC_T11 + l31 * SS + half * 16;
                const LAS unsigned char* bp = lds + SC_XT + l31 * SS + half * 16;
#pragma unroll
                for (int ks = 0; ks < 2; ++ks) x = __builtin_amdgcn_mfma_f32_32x32x16_bf16(*(const LAS bf16x8*)(ap + ks * 32), *(const LAS bf16x8*)(bp + ks * 32), x, 0, 0, 0);
                store_tile_nm(lds + SC_TT, 32, 0, x, l31, half, -1.0f);
            }
        } else if (wid >= 4) {
            const int tbk = ((wid - 4) >> 1) * 32, vbk = ((wid - 4) & 1) * 32;
            f32x16 acc = mm_tile<4>(zero16(), lds + SC_QK, tbk, lds + SC_S0, vbk, l31, half);
            acc = mm_tile<4, false, true>(acc, lds + SC_MK, tbk, lds + SC_VM, vbk, l31, half);
            store_tile_nm(lds + SC_RHS, vbk, tbk, acc, l31, half, 1.0f);
        }
        __syncthreads();
        if (wid < 4) {
            const int tbk = (wid >> 1) * 32, vbk = (wid & 1) * 32;
            f32x16 acc = mm_tile<4>(zero16(), lds + SC_TT, tbk, lds + SC_RHS, vbk, l31, half);
            store_tile_nm(lds + SC_UN, vbk, tbk, acc, l31, half, -1.0f);
        }
        __syncthreads();
        if (wid < 4) {
            const int kbk = (wid >> 1) * 32, vbk = (wid & 1) * 32;
#pragma unroll
            for (int i = 0; i < 16; ++i) st[i] *= WC[kbk + 8 * (i >> 2) + 4 * half + (i & 3)];
            st = mm_tile<4, true, true>(st, lds + SC_KH, kbk, lds + SC_VM, vbk, l31, half);
            st = mm_tile<4, true, false>(st, lds + SC_BH, kbk, lds + SC_UN, vbk, l31, half);
        } else {
            const int vbk = ((wid - 4) >> 1) * 32, tbk = ((wid - 4) & 1) * 32;
            f32x16 acc = mm_tile<4>(zero16(), lds + SC_S0, vbk, lds + SC_RT, tbk, l31, half);
            acc = mm_tile<4, true, false>(acc, lds + SC_VM, vbk, lds + SC_AK, tbk, l31, half);
            acc = mm_tile<4>(acc, lds + SC_UN, vbk, lds + SC_AB, tbk, l31, half);
            LAS float* yp = (LAS float*)(lds + SC_YF) + (tbk + l31) * 68 + vbk + half * 4;
#pragma unroll
            for (int g = 0; g < 4; ++g) *(LAS f32x4*)(yp + g * 8) = (f32x4){acc[4 * g], acc[4 * g + 1], acc[4 * g + 2], acc[4 * g + 3]};
        }
        __syncthreads();
        if (wid < 4) { const int kbk = (wid >> 1) * 32, vbk = (wid & 1) * 32; store_tile_nm(lds + SC_S0, vbk, kbk, st, l31, half, 1.0f); }
        {
            const LAS float* yp = (const LAS float*)(lds + SC_YF) + tl * 68 + k0;
            const f32x4 y0 = *(const LAS f32x4*)yp, y1 = *(const LAS f32x4*)(yp + 4);
            float y[8] = {y0[0], y0[1], y0[2], y0[3], y1[0], y1[1], y1[2], y1[3]};
            float s = y[0] + y[1] + y[2] + y[3] + y[4] + y[5] + y[6] + y[7];
            s += shx(s, lane, 1); s += shx(s, lane, 2); s += shx(s, lane, 4);
            const float mu = s * (1.0f / 64.0f);
            float q = 0.f;
#pragma unroll
            for (int e = 0; e < 8; ++e) { y[e] -= mu; q += y[e] * y[e]; }
            q += shx(q, lane, 1); q += shx(q, lane, 2); q += shx(q, lane, 4);
            const float rs = rsqrtf(q * (1.0f / 64.0f) + 64e-5f);
            float gng[8], gnb[8];
            { const f32x4 a0 = *(const f32x4*)(p.in[I_GNG] + hc), a1 = *(const f32x4*)(p.in[I_GNG] + hc + 4), b0 = *(const f32x4*)(p.in[I_GNB] + hc), b1 = *(const f32x4*)(p.in[I_GNB] + hc + 4);
#pragma unroll
              for (int e = 0; e < 4; ++e) { gng[e] = a0[e]; gng[4 + e] = a1[e]; gnb[e] = b0[e]; gnb[4 + e] = b1[e]; } }
            float o[8];
#pragma unroll
            for (int e = 0; e < 8; ++e) o[e] = (y[e] * rs * gng[e] + gnb[e] + bonus * v_[e]) * g_[e];
            u32x4 w; w.x = cvt_pk_bf16(o[0], o[1]); w.y = cvt_pk_bf16(o[2], o[3]); w.z = cvt_pk_bf16(o[4], o[5]); w.w = cvt_pk_bf16(o[6], o[7]);
            *(u32x4*)(YR + (tok0 + (size_t)c * 64 + tl) * 512 + hc) = w;
        }
    }
    __syncthreads();
}

#define XB_TMO      128
#define XB_XCNT(j)  (256  + 64 * (j))
#define XB_XSUB(j)  (1280 + 64 * (j))
#define XB_XGEN(j)  (2304 + 64 * (j))
#define XB_TOP      3328
#define XB_TOPGEN   3392
#define XCD_BAR_WORDS 3456
#define XB_SPIN_CAP (1u << 18)

__device__ __forceinline__ unsigned xb_ld(unsigned* p)              { return __hip_atomic_load(p, __ATOMIC_RELAXED, __HIP_MEMORY_SCOPE_AGENT); }
__device__ __forceinline__ unsigned xb_add(unsigned* p, unsigned v) { return __hip_atomic_fetch_add(p, v, __ATOMIC_RELAXED, __HIP_MEMORY_SCOPE_AGENT); }
__device__ __forceinline__ unsigned xb_xcc_id() { return (unsigned)__builtin_amdgcn_s_getreg((3 << 11) | 20) & 0xFu; }
#define XB_SPIN(cond, bar) do { unsigned _sp = 0; while (cond) { __builtin_amdgcn_s_sleep(1); \
    if ((++_sp & 255u) == 0u) { if (xb_ld(&(bar)[XB_TMO])) break; if (_sp > XB_SPIN_CAP) { atomicAdd(&(bar)[XB_TMO], 1u); break; } } } } while (0)

struct XcdBarrier {
    unsigned* bar; unsigned x;
    volatile LAS unsigned* st;
};

__device__ __forceinline__ XcdBarrier xcd_barrier_post(unsigned* bar, volatile LAS unsigned* st) {
    XcdBarrier b; b.bar = bar; b.x = xb_xcc_id(); b.st = st;
    if (threadIdx.x == 0) (void)xb_add(&bar[XB_XCNT(b.x)], 1u);
    return b;
}
__device__ __forceinline__ void xcd_barrier_complete(unsigned* bar, unsigned x, unsigned& nloc, unsigned& nx) {
    const unsigned G = gridDim.x * gridDim.y * gridDim.z;
    unsigned sum, cnt, mine, sp = 0u;
    for (;;) {
        sum = 0u; cnt = 0u; mine = 0u;
#pragma unroll
        for (unsigned j = 0; j < 16; ++j) { const unsigned c = xb_ld(&bar[XB_XCNT(j)]); sum += c; cnt += (c > 0u) ? 1u : 0u; mine = (j == x) ? c : mine; }
        if (sum == G) break;
        __builtin_amdgcn_s_sleep(1);
        if ((++sp & 255u) == 0u) { if (xb_ld(&bar[XB_TMO])) break; if (sp > XB_SPIN_CAP) { atomicAdd(&bar[XB_TMO], 1u); break; } }
    }
    nloc = mine > 0u ? mine : 1u; nx = cnt > 0u ? cnt : 1u;
}

__device__ __forceinline__ void xcd_barrier(const XcdBarrier& b) {
    asm volatile("s_waitcnt vmcnt(0)" ::: "memory");
    __syncthreads();
    if (threadIdx.x == 0) {
        unsigned* bar = b.bar;
        __builtin_amdgcn_s_waitcnt(0);
        unsigned nloc = b.st[0], nx = b.st[1];
        if (nloc == 0u) { xcd_barrier_complete(bar, b.x, nloc, nx); b.st[0] = nloc; b.st[1] = nx; }
        const unsigned old = xb_add(&bar[XB_XSUB(b.x)], 1u);
        const unsigned gen = old / nloc;
        if (old + 1u == (gen + 1u) * nloc) {
            __builtin_amdgcn_fence(__ATOMIC_RELEASE, "agent");
            asm volatile("s_waitcnt vmcnt(0)" ::: "memory");
            const unsigned og = xb_add(&bar[XB_TOP], 1u);
            const unsigned tg = og / nx;
            if (og + 1u == (tg + 1u) * nx) xb_add(&bar[XB_TOPGEN], 1u);
            else XB_SPIN(xb_ld(&bar[XB_TOPGEN]) == tg, bar);
            __builtin_amdgcn_fence(__ATOMIC_ACQUIRE, "agent");
            xb_add(&bar[XB_XGEN(b.x)], 1u);
            asm volatile("s_waitcnt vmcnt(0)" ::: "memory");
        } else {
            XB_SPIN(xb_ld(&bar[XB_XGEN(b.x)]) == gen, bar);
            __builtin_amdgcn_fence(__ATOMIC_ACQUIRE, "agent");
            asm volatile("s_waitcnt vmcnt(0)" ::: "memory");
        }
    }
    __syncthreads();
}

typedef const __attribute__((address_space(4))) Params* kparams_t;
__device__ __forceinline__ Params load_params(kparams_t q) { Params r;
#pragma unroll
    for (int i = 0; i < 32; ++i) r.in[i] = q->in[i];
    r.out = q->out; r.ws = q->ws; return r; }
__global__ void __launch_bounds__(512, 2) mk_fwd(Params p_unused) {
    extern __shared__ __attribute__((aligned(16))) unsigned char shm[];
    LAS unsigned char* lds = (LAS unsigned char*)shm;
    int wsg = __builtin_amdgcn_readfirstlane((int)threadIdx.x >> 6); asm volatile("" : "+s"(wsg));
    kparams_t pp = (kparams_t)__builtin_amdgcn_kernarg_segment_ptr();
#define PQ_ ({ asm volatile("" : "+s"(pp)); pp; })
#define P_ (*PQ_)
    unsigned char* ws = P_.ws;
    volatile LAS unsigned* xst = (volatile LAS unsigned*)(lds + LDS_MAIN);
    if (threadIdx.x < 2) xst[threadIdx.x] = 0u;
    __syncthreads();
    (void)xcd_barrier_post((unsigned*)(ws + OFF_BAR), xst);
#define GSYNC() do { XcdBarrier xb_; xb_.bar = (unsigned*)(P_.ws + OFF_BAR); xb_.x = xb_xcc_id(); xb_.st = xst; xcd_barrier(xb_); } while (0)
    bf16_t* actb = (bf16_t*)(ws + OFF_R1);
    bf16_t* hid = (bf16_t*)(ws + OFF_R2);
    bf16_t* zb = (bf16_t*)P_.out;
    bf16_t* z3 = (bf16_t*)(ws + OFF_R3);

    { const Params pl = load_params(PQ_); prologue_phase(wsg, lds, pl); }
    cg::this_grid().sync();
    asm volatile("" : "+s"(wsg) :: "memory");
    { EpiSwiGLU e{hid}; pg8::gemm_phase<NFF1, DM, DM>(wsg, lds, actb, (const bf16_t*)(ws + OFF_W13_1), e); }
    GSYNC();
    asm volatile("" : "+s"(wsg) :: "memory");
    { EpiZ1 e{P_.in[I_X], zb, 0.5f}; pg8::gemm_phase<DM, DFFP, DFFP>(wsg, lds, hid, (const bf16_t*)(ws + OFF_W2_1), e); }
    GSYNC();
    lnz_phase(wsg, zb, P_.in[I_LN1G], P_.in[I_LN1B], (bf16_t*)P_.out + (size_t)T_TOK * DM, nullptr, (float*)(ws + OFF_STAT1));
    GSYNC();
    bf16_t* proj = (bf16_t*)(ws + OFF_R3);
    bf16_t* lin = (bf16_t*)(ws + OFF_R1); bf16_t* qn = (bf16_t*)(ws + OFF_R1 + 48 * MiB); bf16_t* kvn = (bf16_t*)(ws + OFF_R1 + 96 * MiB);
    bf16_t* yr = (bf16_t*)(ws + OFF_R1); bf16_t* ym = (bf16_t*)(ws + OFF_R1 + 64 * MiB);
    bf16_t* qbuf = (bf16_t*)(ws + OFF_R2 + 192 * MiB);
    bf16_t* kn = (bf16_t*)(ws + OFF_R4); bf16_t* vt = (bf16_t*)(ws + OFF_R4 + 64 * MiB); bf16_t* kpe = (bf16_t*)(ws + OFF_R4 + 128 * MiB);
    bf16_t* h1b = (bf16_t*)P_.out + (size_t)T_TOK * DM;
    bf16_t* ubuf = (bf16_t*)(ws + OFF_R2 + 128 * MiB); bf16_t* gates = (bf16_t*)(ws + OFF_R3);
    unsigned* ctl = (unsigned*)(ws + OFF_CTL);
    asm volatile("" : "+s"(wsg) :: "memory");
    { EpiBf16Store<0> e{proj, PROJ_LD}; pg8::gemm_phase<PROJ_LD, DM, DM>(wsg, lds, (const bf16_t*)P_.out + (size_t)T_TOK * DM, (const bf16_t*)(ws + OFF_WIN), e); }
    GSYNC();
    { const Params pl = load_params(PQ_); prep_phase(wsg, pl); }
    GSYNC();
    asm volatile("" : "+s"(wsg) :: "memory");
    { EpiBf16Store<2> e{qbuf, 768}; pg8::gemm_phase<768, 384, 384>(wsg, lds, qn, (const bf16_t*)(ws + OFF_WQ), e); }
    asm volatile("" : "+s"(wsg) :: "memory");
    { EpiKV e{kn, vt}; pg8::gemm_phase<1024, 256, 256>(wsg, lds, kvn, (const bf16_t*)(ws + OFF_WKV), e); }
    asm volatile("" : "+s"(wsg) :: "memory");
    { EpiLoraAll e{(unsigned short*)(ws + OFF_R2), P_.in[I_W0], P_.in[I_A0]}; pg8::gemm_phase<1536, 384, 384>(wsg, lds, lin, (const bf16_t*)(ws + OFF_WLORA), e); }
    GSYNC();
    if (blockIdx.x < 64) { const Params pl = load_params(PQ_); scan_chain(wsg, lds, pl, (int)blockIdx.x); }
    attn_phase(wsg, lds, qbuf, kn, kpe, vt, ym, ctl, (const float*)(ws + OFF_ROPE));
    GSYNC();
    asm volatile("" : "+s"(wsg) :: "memory");
    { EpiBf16Store<1> e{gates, NGATE}; pg8::gemm_phase<NGATE, DM, DM>(wsg, lds, h1b, (const bf16_t*)(ws + OFF_WIN) + (size_t)PROJ_LD * DM, e); }
    GSYNC();
    asm volatile("" : "+s"(wsg) :: "memory");
    { EpiUp<0> e{ubuf, gates, 0}; pg8::gemm_phase<DM, 512, 512>(wsg, lds, yr, (const bf16_t*)(ws + OFF_WUR), e); }
    asm volatile("" : "+s"(wsg) :: "memory");
    { EpiUp<1> e{ubuf, gates, 1024}; pg8::gemm_phase<DM, 512, 512>(wsg, lds, ym, (const bf16_t*)(ws + OFF_WUM), e); }
    GSYNC();
    asm volatile("" : "+s"(wsg) :: "memory");
    { EpiZLN e{zb, zb, 1.0f, (const float*)(ws + OFF_STAT1), P_.in[I_LN1G], P_.in[I_LN1B]}; pg8::gemm_phase<DM, DM, DM>(wsg, lds, ubuf, (const bf16_t*)(ws + OFF_WO), e); }
    GSYNC();
    lnz_phase(wsg, zb, P_.in[I_LN2G], P_.in[I_LN2B], actb, nullptr, (float*)(ws + OFF_STAT2));
    GSYNC();
    asm volatile("" : "+s"(wsg) :: "memory");
    { EpiSwiGLU e{hid}; pg8::gemm_phase<NFF1, DM, DM>(wsg, lds, actb, (const bf16_t*)(ws + OFF_W13_2), e); }
    GSYNC();
    asm volatile("" : "+s"(wsg) :: "memory");
    { EpiZLN e{zb, z3, 0.5f, (const float*)(ws + OFF_STAT2), P_.in[I_LN2G], P_.in[I_LN2B]}; pg8::gemm_phase<DM, DFFP, DFFP>(wsg, lds, hid, (const bf16_t*)(ws + OFF_W2_2), e); }
    GSYNC();
    lnz_phase(wsg, z3, P_.in[I_LN3G], P_.in[I_LN3B], nullptr, P_.out, nullptr);
}

extern "C" void kernel_launch(void* const* d_in, const int* in_sizes, int n_in, void* d_out, int out_size, void* d_ws, size_t ws_size, hipStream_t stream) {
    static int grid = 0;
    if (grid == 0) {
        int dev = 0, cus = 0, per_cu = 0;
        hipGetDevice(&dev);
        hipDeviceGetAttribute(&cus, hipDeviceAttributeMultiprocessorCount, dev);
        if (hipFuncSetAttribute((const void*)mk_fwd, hipFuncAttributeMaxDynamicSharedMemorySize, LDS_BYTES) != hipSuccess) fprintf(stderr, "hipFuncSetAttribute failed\n");
        hipOccupancyMaxActiveBlocksPerMultiprocessor(&per_cu, (const void*)mk_fwd, 512, LDS_BYTES);
        if (per_cu < 1) { fprintf(stderr, "occupancy query says %d blocks/CU\n", per_cu); per_cu = 1; }
        grid = cus;
        if (ws_size < 1024 * MiB) fprintf(stderr, "workspace too small: %zu\n", ws_size);
    }
    Params p{};
    for (int i = 0; i < 32; ++i) p.in[i] = (const float*)d_in[i];
    p.out = (float*)d_out; p.ws = (unsigned char*)d_ws;
    hipMemsetAsync((unsigned char*)d_ws + OFF_CTL, 0, CTL_BYTES, stream);
    void* args[] = {&p};
    hipError_t e = hipLaunchCooperativeKernel((const void*)mk_fwd, dim3(grid), dim3(512), args, LDS_BYTES, stream);
    if (e != hipSuccess) fprintf(stderr, "cooperative launch failed: %s (grid %d)\n", hipGetErrorString(e), grid);
}
```

```cpp
#include <hip/hip_runtime.h>
#include <hip/hip_cooperative_groups.h>
#include <cstdio>
#include <cstdint>
namespace cg = cooperative_groups;

#define LAS __attribute__((address_space(3)))
typedef unsigned short bf16_t;
typedef short bf16x8 __attribute__((ext_vector_type(8)));
typedef float f32x4 __attribute__((ext_vector_type(4)));
typedef float f32x16 __attribute__((ext_vector_type(16)));
typedef unsigned u32x4 __attribute__((ext_vector_type(4)));
typedef unsigned u32x2 __attribute__((ext_vector_type(2)));

constexpr int T_TOK = 65536, SEQ = 8192, DM = 1024, DFF = 2752, DFFP = 2816, NFF1 = 5632;
constexpr int IN_COLS = 4544, PROJ_LD = 2560, NGATE = 2048;
constexpr float ALPHA = 1.189207115002721f;
constexpr int LDS_MAIN = 131072;
constexpr int LDS_BYTES = LDS_MAIN + 64;

constexpr size_t MiB = 1ull << 20;
constexpr size_t OFF_W13_1 = 0;
constexpr size_t OFF_W2_1  = OFF_W13_1 + (size_t)NFF1 * DM * 2;
constexpr size_t OFF_W13_2 = OFF_W2_1 + (size_t)DM * DFFP * 2;
constexpr size_t OFF_W2_2  = OFF_W13_2 + (size_t)NFF1 * DM * 2;
constexpr size_t OFF_WIN   = OFF_W2_2 + (size_t)DM * DFFP * 2;
constexpr size_t OFF_WLORA = OFF_WIN + (size_t)4608 * DM * 2;
constexpr size_t OFF_WQ    = OFF_WLORA + (size_t)1536 * 384 * 2;
constexpr size_t OFF_WKV   = OFF_WQ + (size_t)768 * 384 * 2;
constexpr size_t OFF_WUR   = OFF_WKV + (size_t)1024 * 256 * 2;
constexpr size_t OFF_WUM   = OFF_WUR + (size_t)1024 * 512 * 2;
constexpr size_t OFF_WO    = OFF_WUM + (size_t)1024 * 512 * 2;
constexpr size_t OFF_ROPE  = OFF_WO + (size_t)1024 * 1024 * 2;
constexpr size_t OFF_CTL   = OFF_ROPE + (size_t)2 * 8192 * 16 * 4;
constexpr size_t OFF_BAR   = OFF_CTL + 4096;
constexpr size_t CTL_BYTES = 4096 + 3456 * 4;
constexpr size_t OFF_STAT1 = OFF_CTL + 32768;
constexpr size_t OFF_STAT2 = OFF_STAT1 + (size_t)65536 * 8;
constexpr size_t OFF_R1    = 56 * MiB;
constexpr size_t OFF_R2    = 184 * MiB;
constexpr size_t OFF_R3    = 536 * MiB;
constexpr size_t OFF_R4    = 856 * MiB;
static_assert(OFF_STAT2 + (size_t)65536 * 8 <= OFF_R1 && CTL_BYTES <= 32768, "weights overflow");

struct Params { const float* in[32]; float* out; unsigned char* ws; };

enum { I_X = 0, I_F1W1, I_F1W3, I_F1W2, I_LN1G, I_LN1B, I_WIN, I_MU, I_W0, I_WDU, I_A0, I_WIU, I_WGU, I_KK, I_KA, I_RK, I_GNG, I_GNB,
       I_QNG, I_WQU, I_KVNG, I_WKVU, I_WUR, I_WUM, I_WO, I_LN2G, I_LN2B, I_F2W1, I_F2W3, I_F2W2, I_LN3G, I_LN3B };

typedef __bf16 bf16v2_t __attribute__((ext_vector_type(2)));
typedef float f32v2_t __attribute__((ext_vector_type(2)));
__device__ __forceinline__ unsigned cvt_pk_bf16(float lo, float hi) { f32v2_t v = {lo, hi}; bf16v2_t b = __builtin_convertvector(v, bf16v2_t); return __builtin_bit_cast(unsigned, b); }
__device__ __forceinline__ float bflo(unsigned w) { return __uint_as_float(w << 16); }
__device__ __forceinline__ float bfhi(unsigned w) { return __uint_as_float(w & 0xffff0000u); }
__device__ __forceinline__ int otid(int wsg) { int l; asm volatile("v_mbcnt_lo_u32_b32 %0, -1, 0\n\tv_mbcnt_hi_u32_b32 %0, -1, %0" : "=v"(l)); return wsg * 64 + l; }
__device__ __forceinline__ float shx(float v, int lane, int m) { return __int_as_float(__builtin_amdgcn_ds_bpermute((lane ^ m) << 2, __float_as_int(v))); }
__device__ __forceinline__ float bf2f(bf16_t b) { return __uint_as_float(((unsigned)b) << 16); }

namespace pg8 {
constexpr int BM = 256, BK = 64, HALF = 128, HTB = HALF * BK * 2, STAGE_BYTES = 8 * HTB, NXCD = 8, WGM = 8;
__host__ __device__ __forceinline__ int lds_byte(int r, int c) { const int st = (r >> 4) * 2 + (c >> 5), rr = r & 15, cc = c & 31, ob = rr * 64 + cc * 2; return st * 1024 + (ob ^ (((ob >> 9) & 1) << 5)); }
__host__ __device__ __forceinline__ void stage_rc(int b, int& R, int& C) { const int st = b / 1024, sb = b % 1024, swz = sb ^ (((sb >> 9) & 1) << 5); R = (st >> 1) * 16 + swz / 64; C = (st & 1) * 32 + (swz % 64) / 2; }
__host__ __device__ __forceinline__ int perm32(int rho) { const int n = rho >> 4, i = rho & 15; return 8 * (i >> 2) + 4 * n + (i & 3); }
struct Unit { int pm, pn; };
struct Gemm { const bf16_t* A; int lda; const bf16_t* Bt; int M, N, K; };
struct StaticOrder {
    int nM, nN, nwg, G, c;
    __device__ void init(int M, int N, int G_, int c_) { nM = M / BM; nN = N / BM; nwg = nM * nN; G = G_; c = c_; }
    __device__ bool next(int i, Unit& u) const {
        const long L = (long)i * G + c; if (L >= nwg) return false;
        int wgid = (int)L; { const int q = nwg / NXCD, r = nwg % NXCD, xcd = wgid % NXCD, off = wgid / NXCD; wgid = (xcd < r ? xcd * (q + 1) : r * (q + 1) + (xcd - r) * q) + off; }
        const int nig = WGM * nN, gid = wgid / nig, fm = gid * WGM, gsz = (nM - fm) < WGM ? (nM - fm) : WGM;
        u.pm = fm + ((wgid % nig) % gsz); u.pn = (wgid % nig) / gsz; return true;
    }
};

template <int N_, int K_, int LDA_, class Epi>
__device__ __forceinline__ void gemm_phase(int wsg, LAS unsigned char* lds, const bf16_t* gA, const bf16_t* gBt, const Epi& E) {
    struct { const bf16_t* A; const bf16_t* Bt; } g{gA, gBt};
    StaticOrder S; S.init(T_TOK, N_, (int)gridDim.x, (int)blockIdx.x);
    const int tid_ = otid(wsg);
    const int tid = tid_, wid = __builtin_amdgcn_readfirstlane(tid >> 6), lane = tid & 63, wr = wid >> 2, wc = wid & 3, fr = lane & 15, fq = lane >> 4;
    constexpr int K = K_, nt = K / BK, lda = LDA_;
    unsigned voffA[2], voffB[2];
#pragma unroll
    for (int i = 0; i < 2; ++i) { int R, C; stage_rc(tid * 16 + i * 8192, R, C); const int Rb = Epi::PERM ? ((R & ~31) + perm32(R & 31)) : R;
        voffA[i] = (unsigned)(R * lda + C) * 2u; voffB[i] = (unsigned)(Rb * K + C) * 2u; }
    constexpr size_t kstep = (size_t)(BK * 2);
    constexpr size_t hstepA = (size_t)HALF * lda * 2, hstepB = (size_t)HALF * K * 2;
    constexpr size_t tstepA = 2 * hstepA, tstepB = 2 * hstepB;
    const unsigned ldsw = (unsigned)wid * 1024u;
    const int aoff = lds_byte(wr * 64 + fr, fq * 8), boff = lds_byte(wc * 32 + fr, fq * 8);
#define PG8_SA(b, h) (((b) * 2 + (h)) * HTB)
#define PG8_SB(b, h) ((4 + (b) * 2 + (h)) * HTB)
#define PG8_STAGE(bufoff, gbase, voff) do { _Pragma("unroll") for (int _i = 0; _i < 2; ++_i) \
        __builtin_amdgcn_global_load_lds((const unsigned*)((const char*)(gbase) + (voff)[_i]), (LAS unsigned*)(lds + (bufoff) + ldsw + _i * 8192), 16, 0, 0); } while (0)
#define PG8_LDA(dst, b, h) do { _Pragma("unroll") for (int m = 0; m < 4; ++m) _Pragma("unroll") for (int k = 0; k < 2; ++k) dst[m][k] = *(const LAS bf16x8*)(lds + PG8_SA(b, h) + aoff + m * 2048 + k * 1024); } while (0)
#define PG8_LDB(dst, b, h) do { _Pragma("unroll") for (int n = 0; n < 2; ++n) _Pragma("unroll") for (int k = 0; k < 2; ++k) dst[n][k] = *(const LAS bf16x8*)(lds + PG8_SB(b, h) + boff + n * 2048 + k * 1024); } while (0)
#define PG8_MMA(ai, bj, At, Bt) do { __builtin_amdgcn_s_setprio(1); _Pragma("unroll") for (int m = 0; m < 4; ++m) _Pragma("unroll") for (int n = 0; n < 2; ++n) _Pragma("unroll") for (int k = 0; k < 2; ++k) \
        acc[ai][bj][m][n] = __builtin_amdgcn_mfma_f32_16x16x32_bf16(Bt[n][k], At[m][k], acc[ai][bj][m][n], 0, 0, 0); __builtin_amdgcn_s_setprio(0); } while (0)
#define PG8_WAIT_V(n) asm volatile("s_waitcnt vmcnt(" #n ")" ::: "memory")
#define PG8_WAIT_L(n) asm volatile("s_waitcnt lgkmcnt(" #n ")" ::: "memory")
#define PG8_BAR __builtin_amdgcn_s_barrier()
#define PG8_SCHED __builtin_amdgcn_sched_barrier(0)
    Unit cur, nxt; int ui = 0;
    if (!S.next(0, cur)) return;
    f32x4 acc[2][2][4][2];
#pragma unroll
    for (int a = 0; a < 2; ++a)
#pragma unroll
        for (int b = 0; b < 2; ++b)
#pragma unroll
            for (int m = 0; m < 4; ++m)
#pragma unroll
                for (int n = 0; n < 2; ++n) acc[a][b][m][n] = (f32x4){0.f, 0.f, 0.f, 0.f};
    bf16x8 At[4][2], B0[2][2], B1[2][2];
    const char* cA = (const char*)g.A + (size_t)cur.pm * tstepA; const char* cB = (const char*)g.Bt + (size_t)cur.pn * tstepB;
    PG8_STAGE(PG8_SB(0, 0), cB, voffB); PG8_STAGE(PG8_SB(0, 1), cB + hstepB, voffB); PG8_STAGE(PG8_SA(0, 0), cA, voffA); PG8_STAGE(PG8_SA(0, 1), cA + hstepA, voffA);
    if (wr == 1) PG8_BAR;
    PG8_WAIT_V(2); PG8_BAR;
    PG8_STAGE(PG8_SB(1, 0), cB + kstep, voffB); PG8_STAGE(PG8_SA(1, 0), cA + kstep, voffA); PG8_STAGE(PG8_SB(1, 1), cB + hstepB + kstep, voffB);
    PG8_WAIT_V(6); PG8_BAR;
    for (;;) {
        const bool has_next = S.next(ui + 1, nxt);
        const char* nA = has_next ? (const char*)g.A + (size_t)nxt.pm * tstepA : cA; const char* nB = has_next ? (const char*)g.Bt + (size_t)nxt.pn * tstepB : cB;
#pragma unroll 1
        for (int t = 0; t < nt; t += 2) {
            const bool last = (t == nt - 2);
            const char* a1 = cA + (size_t)(t + 1) * kstep;
            const char* a2 = last ? nA : cA + (size_t)(t + 2) * kstep; const char* b2 = last ? nB : cB + (size_t)(t + 2) * kstep;
            const char* a3 = a2 + kstep; const char* b3 = b2 + kstep;
            PG8_LDB(B0, 0, 0); PG8_LDB(B1, 0, 1); PG8_SCHED; PG8_LDA(At, 0, 0); PG8_STAGE(PG8_SA(1, 1), a1 + hstepA, voffA);
            PG8_WAIT_V(8); PG8_WAIT_L(0); PG8_BAR; PG8_MMA(0, 0, At, B0); PG8_MMA(0, 1, At, B1); PG8_BAR; PG8_SCHED;
            PG8_LDA(At, 0, 1); PG8_STAGE(PG8_SB(0, 0), b2, voffB); PG8_STAGE(PG8_SB(0, 1), b2 + hstepB, voffB); PG8_STAGE(PG8_SA(0, 0), a2, voffA);
            PG8_WAIT_V(8); PG8_WAIT_L(0); PG8_BAR; PG8_MMA(1, 0, At, B0); PG8_MMA(1, 1, At, B1); PG8_BAR; PG8_SCHED;
            PG8_LDB(B0, 1, 0); PG8_LDB(B1, 1, 1); PG8_SCHED; PG8_LDA(At, 1, 0); PG8_STAGE(PG8_SA(0, 1), a2 + hstepA, voffA);
            PG8_WAIT_V(8); PG8_WAIT_L(0); PG8_BAR; PG8_MMA(0, 0, At, B0); PG8_MMA(0, 1, At, B1); PG8_BAR; PG8_SCHED;
            PG8_LDA(At, 1, 1); PG8_STAGE(PG8_SB(1, 0), b3, voffB); PG8_STAGE(PG8_SB(1, 1), b3 + hstepB, voffB); PG8_STAGE(PG8_SA(1, 0), a3, voffA);
            PG8_WAIT_V(8); PG8_WAIT_L(0); PG8_BAR; PG8_MMA(1, 0, At, B0); PG8_MMA(1, 1, At, B1); PG8_BAR; PG8_SCHED;
        }
        if (wr == 0) PG8_BAR;
        E(acc, cur, wr, wc, fr, fq);
        if (!has_next) break;
#pragma unroll
        for (int a = 0; a < 2; ++a)
#pragma unroll
            for (int b = 0; b < 2; ++b)
#pragma unroll
                for (int m = 0; m < 4; ++m)
#pragma unroll
                    for (int n = 0; n < 2; ++n) acc[a][b][m][n] = (f32x4){0.f, 0.f, 0.f, 0.f};
        cur = nxt; cA = nA; cB = nB; ++ui;
        if (wr == 1) PG8_BAR;
    }
    PG8_WAIT_V(0);
    PG8_BAR;
#undef PG8_SA
#undef PG8_SB
#undef PG8_STAGE
#undef PG8_LDA
#undef PG8_LDB
#undef PG8_MMA
#undef PG8_WAIT_V
#undef PG8_WAIT_L
#undef PG8_BAR
#undef PG8_SCHED
}
}
using pg8::Unit;


struct EpiSwiGLU {
    static constexpr bool PERM = true;
    bf16_t* O;
    __device__ __forceinline__ void operator()(const f32x4 (&acc)[2][2][4][2], const Unit& u, int wr, int wc, int fr, int fq) const {
        const int row0 = u.pm * 256 + wr * 64 + fr, col0 = u.pn * 128 + wc * 32 + 8 * fq;
#pragma unroll
        for (int ai = 0; ai < 2; ++ai)
#pragma unroll
            for (int m = 0; m < 4; ++m) {
                float h[8];
#pragma unroll
                for (int n = 0; n < 2; ++n)
#pragma unroll
                    for (int j = 0; j < 4; ++j) { const float gt = acc[ai][0][m][n][j], up = acc[ai][1][m][n][j]; h[n * 4 + j] = gt * up * __builtin_amdgcn_rcpf(1.0f + __builtin_amdgcn_exp2f(-gt)); }
                u32x4 w; w.x = cvt_pk_bf16(h[0], h[1]); w.y = cvt_pk_bf16(h[2], h[3]); w.z = cvt_pk_bf16(h[4], h[5]); w.w = cvt_pk_bf16(h[6], h[7]);
                __builtin_nontemporal_store(w, (u32x4*)(O + (size_t)(row0 + ai * 128 + m * 16) * DFFP + col0));
            }
    }
};
struct EpiResid {
    static constexpr bool PERM = false;
    const float* res; float* out; float sc;
    __device__ __forceinline__ void operator()(const f32x4 (&acc)[2][2][4][2], const Unit& u, int wr, int wc, int fr, int fq) const {
        const int row0 = u.pm * 256 + wr * 64 + fr, col0 = u.pn * 256 + wc * 32 + 4 * fq;
#pragma unroll
        for (int ai = 0; ai < 2; ++ai)
#pragma unroll
            for (int m = 0; m < 4; ++m) {
                const size_t ro = (size_t)(row0 + ai * 128 + m * 16) * DM + col0;
                f32x4 rv[2][2];
#pragma unroll
                for (int bj = 0; bj < 2; ++bj)
#pragma unroll
                    for (int n = 0; n < 2; ++n) rv[bj][n] = *(const f32x4*)(res + ro + bj * 128 + n * 16);
#pragma unroll
                for (int bj = 0; bj < 2; ++bj)
#pragma unroll
                    for (int n = 0; n < 2; ++n) *(f32x4*)(out + ro + bj * 128 + n * 16) = rv[bj][n] * ALPHA + acc[ai][bj][m][n] * sc;
            }
    }
};


constexpr float QSCALE = 0.10206207261596575f * 1.4426950408889634f;
template <int MODE  > struct EpiBf16Store {
    static constexpr bool PERM = true;
    bf16_t* O; int ldc;
    __device__ __forceinline__ void operator()(const f32x4 (&acc)[2][2][4][2], const Unit& u, int wr, int wc, int fr, int fq) const {
        const int row0 = u.pm * 256 + wr * 64 + fr, col0 = u.pn * 256 + wc * 32 + 8 * fq;
#pragma unroll
        for (int ai = 0; ai < 2; ++ai)
#pragma unroll
            for (int m = 0; m < 4; ++m)
#pragma unroll
                for (int bj = 0; bj < 2; ++bj) {
                    float h[8];
#pragma unroll
                    for (int n = 0; n < 2; ++n)
#pragma unroll
                        for (int j = 0; j < 4; ++j) { const float v = acc[ai][bj][m][n][j]; h[n * 4 + j] = MODE == 1 ? __builtin_amdgcn_rcpf(1.0f + __builtin_amdgcn_exp2f(-v)) : (MODE == 2 ? v * QSCALE : v); }
                    u32x4 w; w.x = cvt_pk_bf16(h[0], h[1]); w.y = cvt_pk_bf16(h[2], h[3]); w.z = cvt_pk_bf16(h[4], h[5]); w.w = cvt_pk_bf16(h[6], h[7]);
                    __builtin_nontemporal_store(w, (u32x4*)(O + (size_t)(row0 + ai * 128 + m * 16) * ldc + col0 + bj * 128));
                }
    }
};
struct EpiKV {
    static constexpr bool PERM = true;
    bf16_t* KN; bf16_t* VT;
    __device__ __forceinline__ void operator()(const f32x4 (&acc)[2][2][4][2], const Unit& u, int wr, int wc, int fr, int fq) const {
        const int row0 = u.pm * 256 + wr * 64 + fr, col0 = u.pn * 256 + wc * 32 + 8 * fq;
#pragma unroll
        for (int ai = 0; ai < 2; ++ai)
#pragma unroll
            for (int m = 0; m < 4; ++m) {
                const int row = row0 + ai * 128 + m * 16, pos = row & (SEQ - 1), b = row >> 13;
#pragma unroll
                for (int bj = 0; bj < 2; ++bj) {
                    const int c0 = col0 + bj * 128, hd = c0 >> 7, within = c0 & 127;
                    float h[8];
#pragma unroll
                    for (int n = 0; n < 2; ++n)
#pragma unroll
                        for (int j = 0; j < 4; ++j) h[n * 4 + j] = acc[ai][bj][m][n][j];
                    u32x4 w; w.x = cvt_pk_bf16(h[0], h[1]); w.y = cvt_pk_bf16(h[2], h[3]); w.z = cvt_pk_bf16(h[4], h[5]); w.w = cvt_pk_bf16(h[6], h[7]);
                    if (within < 64) { __builtin_nontemporal_store(w, (u32x4*)(KN + (size_t)row * 512 + hd * 64 + within)); }
                    else {
                        bf16_t* vp = VT + ((size_t)((b * 8 + hd) * 64 + (within - 64))) * SEQ + pos;
                        vp[0 * SEQ] = (bf16_t)(w.x & 0xffffu); vp[1 * SEQ] = (bf16_t)(w.x >> 16); vp[2 * SEQ] = (bf16_t)(w.y & 0xffffu); vp[3 * SEQ] = (bf16_t)(w.y >> 16);
                        vp[4 * SEQ] = (bf16_t)(w.z & 0xffffu); vp[5 * SEQ] = (bf16_t)(w.z >> 16); vp[6 * SEQ] = (bf16_t)(w.w & 0xffffu); vp[7 * SEQ] = (bf16_t)(w.w >> 16);
                    }
                }
            }
    }
};
template <int MODE> struct EpiUp {
    static constexpr bool PERM = true;
    bf16_t* U; const bf16_t* G; int goff;
    __device__ __forceinline__ void operator()(const f32x4 (&acc)[2][2][4][2], const Unit& u, int wr, int wc, int fr, int fq) const {
        const int row0 = u.pm * 256 + wr * 64 + fr, col0 = u.pn * 256 + wc * 32 + 8 * fq;
#pragma unroll
        for (int ai = 0; ai < 2; ++ai)
#pragma unroll
            for (int m = 0; m < 4; ++m)
#pragma unroll
                for (int bj = 0; bj < 2; ++bj) {
                    const size_t row = (size_t)(row0 + ai * 128 + m * 16); const int c0 = col0 + bj * 128;
                    const u32x4 gw = *(const u32x4*)(G + row * NGATE + goff + c0);
                    float h[8];
#pragma unroll
                    for (int n = 0; n < 2; ++n)
#pragma unroll
                        for (int j = 0; j < 4; ++j) h[n * 4 + j] = acc[ai][bj][m][n][j];
                    h[0] *= bflo(gw.x); h[1] *= bfhi(gw.x); h[2] *= bflo(gw.y); h[3] *= bfhi(gw.y); h[4] *= bflo(gw.z); h[5] *= bfhi(gw.z); h[6] *= bflo(gw.w); h[7] *= bfhi(gw.w);
                    if (MODE == 1) { const u32x4 uw = *(const u32x4*)(U + row * DM + c0);
                        h[0] += bflo(uw.x); h[1] += bfhi(uw.x); h[2] += bflo(uw.y); h[3] += bfhi(uw.y); h[4] += bflo(uw.z); h[5] += bfhi(uw.z); h[6] += bflo(uw.w); h[7] += bfhi(uw.w); }
                    u32x4 w; w.x = cvt_pk_bf16(h[0], h[1]); w.y = cvt_pk_bf16(h[2], h[3]); w.z = cvt_pk_bf16(h[4], h[5]); w.w = cvt_pk_bf16(h[6], h[7]);
                    *(u32x4*)(U + row * DM + c0) = w;
                }
    }
};

typedef _Float16 f16v2_t __attribute__((ext_vector_type(2)));
__device__ __forceinline__ unsigned cvt_pk_f16(float lo, float hi) { f32v2_t v = {lo, hi}; f16v2_t b = __builtin_convertvector(v, f16v2_t); return __builtin_bit_cast(unsigned, b); }
__device__ __forceinline__ float f16lo(unsigned w) { f16v2_t b = __builtin_bit_cast(f16v2_t, w); return (float)b[0]; }
__device__ __forceinline__ float f16hi(unsigned w) { f16v2_t b = __builtin_bit_cast(f16v2_t, w); return (float)b[1]; }
template <int KIND> struct EpiLora {
    static constexpr bool PERM = true;
    unsigned short* O; const float* bias;
    __device__ __forceinline__ void operator()(const f32x4 (&acc)[2][2][4][2], const Unit& u, int wr, int wc, int fr, int fq) const {
        const int row0 = u.pm * 256 + wr * 64 + fr, col0 = u.pn * 256 + wc * 32 + 8 * fq;
#pragma unroll
        for (int ai = 0; ai < 2; ++ai)
#pragma unroll
            for (int m = 0; m < 4; ++m)
#pragma unroll
                for (int bj = 0; bj < 2; ++bj) {
                    const int c0 = col0 + bj * 128;
                    f32x4 b0 = (f32x4){0.f, 0.f, 0.f, 0.f}, b1 = b0;
                    if (KIND != 2) { b0 = *(const f32x4*)(bias + c0); b1 = *(const f32x4*)(bias + c0 + 4); }
                    float h[8];
#pragma unroll
                    for (int n = 0; n < 2; ++n)
#pragma unroll
                        for (int j = 0; j < 4; ++j) {
                            const float x = acc[ai][bj][m][n][j] + (n == 0 ? b0[j] : b1[j]);
                            float o;
                            if (KIND == 0) o = 0.6065306597126334f * __builtin_amdgcn_rcpf(1.0f + __expf(-x));
                            else if (KIND == 1) o = __builtin_amdgcn_rcpf(1.0f + __expf(-x));
                            else o = x;
                            h[n * 4 + j] = o;
                        }
                    u32x4 w; w.x = cvt_pk_f16(h[0], h[1]); w.y = cvt_pk_f16(h[2], h[3]); w.z = cvt_pk_f16(h[4], h[5]); w.w = cvt_pk_f16(h[6], h[7]);
                    __builtin_nontemporal_store(w, (u32x4*)(O + (size_t)(row0 + ai * 128 + m * 16) * 1536 + c0));
                }
    }
};

struct EpiResidLN {
    static constexpr bool PERM = false;
    const float* z; float* out; float sc; const float* stat; const float* g; const float* b;
    __device__ __forceinline__ void operator()(const f32x4 (&acc)[2][2][4][2], const Unit& u, int wr, int wc, int fr, int fq) const {
        const int row0 = u.pm * 256 + wr * 64 + fr, col0 = u.pn * 256 + wc * 32 + 4 * fq;
#pragma unroll
        for (int ai = 0; ai < 2; ++ai)
#pragma unroll
            for (int m = 0; m < 4; ++m) {
                __builtin_amdgcn_sched_barrier(0);
                const int row = row0 + ai * 128 + m * 16;
                const size_t ro = (size_t)row * DM + col0;
                const float mu = stat[2 * row], rs = stat[2 * row + 1];
#pragma unroll
                for (int bj = 0; bj < 2; ++bj)
#pragma unroll
                    for (int n = 0; n < 2; ++n) {
                        const f32x4 zv = *(const f32x4*)(z + ro + bj * 128 + n * 16);
                        const f32x4 gv = *(const f32x4*)(g + col0 + bj * 128 + n * 16), bv = *(const f32x4*)(b + col0 + bj * 128 + n * 16);
                        const f32x4 h = (zv - mu) * rs * gv + bv;
                        *(f32x4*)(out + ro + bj * 128 + n * 16) = h * ALPHA + acc[ai][bj][m][n] * sc;
                    }
            }
    }
};

struct EpiZ1 {
    static constexpr bool PERM = true;
    const float* x; bf16_t* z; float sc;
    __device__ __forceinline__ void operator()(const f32x4 (&acc)[2][2][4][2], const Unit& u, int wr, int wc, int fr, int fq) const {
        const int row0 = u.pm * 256 + wr * 64 + fr, col0 = u.pn * 256 + wc * 32 + 8 * fq;
#pragma unroll
        for (int ai = 0; ai < 2; ++ai)
#pragma unroll
            for (int m = 0; m < 4; ++m) {
#pragma unroll
                for (int bj = 0; bj < 2; ++bj) {
                    const size_t o = (size_t)(row0 + ai * 128 + m * 16) * DM + col0 + bj * 128;
                    const f32x4 x0 = *(const f32x4*)(x + o), x1 = *(const f32x4*)(x + o + 4);
                    const f32x4 r0 = x0 * ALPHA + acc[ai][bj][m][0] * sc, r1 = x1 * ALPHA + acc[ai][bj][m][1] * sc;
                    u32x4 w; w.x = cvt_pk_bf16(r0[0], r0[1]); w.y = cvt_pk_bf16(r0[2], r0[3]); w.z = cvt_pk_bf16(r1[0], r1[1]); w.w = cvt_pk_bf16(r1[2], r1[3]);
                    __builtin_nontemporal_store(w, (u32x4*)(z + o));
                }
            }
    }
};
struct EpiZLN {
    static constexpr bool PERM = true;
    const bf16_t* zin; bf16_t* zout; float sc; const float* stat; const float* g; const float* b;
    __device__ __forceinline__ void operator()(const f32x4 (&acc)[2][2][4][2], const Unit& u, int wr, int wc, int fr, int fq) const {
        const int row0 = u.pm * 256 + wr * 64 + fr, col0 = u.pn * 256 + wc * 32 + 8 * fq;
#pragma unroll
        for (int ai = 0; ai < 2; ++ai)
#pragma unroll
            for (int m = 0; m < 4; ++m) {
                const int row = row0 + ai * 128 + m * 16;
                const float mu = stat[2 * row], rs = stat[2 * row + 1];
#pragma unroll
                for (int bj = 0; bj < 2; ++bj) {
                    const int c0 = col0 + bj * 128;
                    const size_t o = (size_t)row * DM + c0;
                    const u32x4 zw = *(const u32x4*)(zin + o);
                    const f32x4 g0 = *(const f32x4*)(g + c0), g1 = *(const f32x4*)(g + c0 + 4), b0 = *(const f32x4*)(b + c0), b1 = *(const f32x4*)(b + c0 + 4);
                    const f32x4 z0 = (f32x4){bflo(zw.x), bfhi(zw.x), bflo(zw.y), bfhi(zw.y)}, z1 = (f32x4){bflo(zw.z), bfhi(zw.z), bflo(zw.w), bfhi(zw.w)};
                    const f32x4 h0 = (z0 - mu) * rs * g0 + b0, h1 = (z1 - mu) * rs * g1 + b1;
                    const f32x4 r0 = h0 * ALPHA + acc[ai][bj][m][0] * sc, r1 = h1 * ALPHA + acc[ai][bj][m][1] * sc;
                    u32x4 w; w.x = cvt_pk_bf16(r0[0], r0[1]); w.y = cvt_pk_bf16(r0[2], r0[3]); w.z = cvt_pk_bf16(r1[0], r1[1]); w.w = cvt_pk_bf16(r1[2], r1[3]);
                    __builtin_nontemporal_store(w, (u32x4*)(zout + o));
                }
            }
    }
};

struct EpiLoraAll {
    static constexpr bool PERM = true;
    unsigned short* O; const float* w0; const float* a0;
    __device__ __forceinline__ void operator()(const f32x4 (&acc)[2][2][4][2], const Unit& u, int wr, int wc, int fr, int fq) const {
        const int kind = u.pn >> 1;
        Unit v; v.pm = u.pm; v.pn = u.pn & 1;
        if (kind == 0) { EpiLora<0> e{O, w0}; e(acc, v, wr, wc, fr, fq); }
        else if (kind == 1) { EpiLora<1> e{O + 512, a0}; e(acc, v, wr, wc, fr, fq); }
        else { EpiLora<2> e{O + 1024, nullptr}; e(acc, v, wr, wc, fr, fq); }
    }
};
template <class F>
__device__ __forceinline__ void cvt_job(int wsg, LAS unsigned char* lds, bf16_t* dst, int Np, int Kp, F f) {
    const int tid = otid(wsg);
    const int ntn = Np / 64, ntk = Kp / 64, ntiles = ntn * ntk;
    LAS bf16_t* T = (LAS bf16_t*)lds;
    for (int t = blockIdx.x; t < ntiles; t += gridDim.x) {
        const int n0 = (t % ntn) * 64, k0 = (t / ntn) * 64;
        __syncthreads();
#pragma unroll
        for (int i = 0; i < 8; ++i) {
            const int n = tid & 63, k = (tid >> 6) + 8 * i;
            const float v = f(n0 + n, k0 + k);
            T[n * 66 + k] = (bf16_t)(cvt_pk_bf16(v, 0.f) & 0xffffu);
        }
        __syncthreads();
        {
            const int n = tid >> 3, ks = (tid & 7) * 8;
            const LAS unsigned* rp = (const LAS unsigned*)(T + n * 66 + ks);
            u32x4 w; w.x = rp[0]; w.y = rp[1]; w.z = rp[2]; w.w = rp[3];
            *(u32x4*)(dst + (size_t)(n0 + n) * Kp + k0 + ks) = w;
        }
    }
}

__device__ void prologue_phase(int wsg, LAS unsigned char* lds, const Params& p) {
    unsigned char* ws = p.ws;
#pragma unroll 1
    for (int f = 0; f < 2; ++f) {
        const float* w1 = p.in[f ? I_F2W1 : I_F1W1]; const float* w3 = p.in[f ? I_F2W3 : I_F1W3]; const float* w2 = p.in[f ? I_F2W2 : I_F1W2];
        cvt_job(wsg, lds, (bf16_t*)(ws + (f ? OFF_W13_2 : OFF_W13_1)), NFF1, DM, [=](int n, int k) -> float {
            const int pn = n >> 8, half = (n >> 7) & 1, c = pn * 128 + (n & 127);
            return c < DFF ? (half ? w3[(size_t)k * DFF + c] * 0.6931471805599453f : w1[(size_t)k * DFF + c] * 1.4426950408889634f) : 0.f; });
        cvt_job(wsg, lds, (bf16_t*)(ws + (f ? OFF_W2_2 : OFF_W2_1)), DM, DFFP, [=](int n, int k) -> float { return k < DFF ? w2[(size_t)k * DM + n] : 0.f; });
    }
    {
        const float* w = p.in[I_WIN];
        cvt_job(wsg, lds, (bf16_t*)(ws + OFF_WIN), 4608, DM, [=](int n, int k) -> float {
            const int c = n < 2496 ? n : (n < 2560 ? -1 : n - 64);
            return c < 0 ? 0.f : w[(size_t)k * IN_COLS + c] * (n >= 2560 ? 1.4426950408889634f : 1.0f); });
    }
    {
        const float* wd = p.in[I_WDU]; const float* wi = p.in[I_WIU]; const float* wg = p.in[I_WGU];
        cvt_job(wsg, lds, (bf16_t*)(ws + OFF_WLORA), 1536, 384, [=](int n, int k) -> float {
            if (n < 512) return k < 64 ? wd[k * 512 + n] : 0.f;
            if (n < 1024) return (k >= 64 && k < 128) ? wi[(k - 64) * 512 + (n - 512)] : 0.f;
            return (k >= 128 && k < 288) ? wg[(k - 128) * 512 + (n - 1024)] : 0.f; });
    }
    {
        const float* w = p.in[I_WQU];
        cvt_job(wsg, lds, (bf16_t*)(ws + OFF_WQ), 768, 384, [=](int n, int k) -> float {
            const int hd = n / 96, s = n % 96; int o = s;
            if (s >= 64) { const int pp = s - 64, i = pp >> 1; o = 64 + ((pp & 1) ? i + 16 : i); }
            return w[k * 768 + hd * 96 + o]; });
    }
    { const float* w = p.in[I_WKVU]; cvt_job(wsg, lds, (bf16_t*)(ws + OFF_WKV), 1024, 256, [=](int n, int k) -> float { return w[k * 1024 + n]; }); }
    { const float* w = p.in[I_WUR]; cvt_job(wsg, lds, (bf16_t*)(ws + OFF_WUR), 1024, 512, [=](int n, int k) -> float { return w[k * 1024 + n]; }); }
    { const float* w = p.in[I_WUM]; cvt_job(wsg, lds, (bf16_t*)(ws + OFF_WUM), 1024, 512, [=](int n, int k) -> float { return w[k * 1024 + n]; }); }
    { const float* w = p.in[I_WO]; cvt_job(wsg, lds, (bf16_t*)(ws + OFF_WO), 1024, 1024, [=](int n, int k) -> float { return w[k * 1024 + n]; }); }
    {
        float* rc = (float*)(ws + OFF_ROPE);
        const int gstride = gridDim.x * 512;
        for (int i = blockIdx.x * 512 + otid(wsg); i < 8192 * 16; i += gstride) {
            const int pos = i >> 4, f = i & 15;
            const float inv = powf(10000.0f, -(float)f * (1.0f / 16.0f));
            const float ang = (float)pos * inv;
            rc[i] = cosf(ang); rc[8192 * 16 + i] = sinf(ang);
        }
    }
    {
        const float* x = p.in[I_X]; bf16_t* xb = (bf16_t*)(ws + OFF_R1);
        const long total = (long)T_TOK * DM / 8, gstride = (long)gridDim.x * 512;
        for (long i = (long)blockIdx.x * 512 + otid(wsg); i < total; i += gstride) {
            const f32x4 a = __builtin_nontemporal_load((const f32x4*)(x + i * 8)), b = __builtin_nontemporal_load((const f32x4*)(x + i * 8 + 4));
            u32x4 w; w.x = cvt_pk_bf16(a[0], a[1]); w.y = cvt_pk_bf16(a[2], a[3]); w.z = cvt_pk_bf16(b[0], b[1]); w.w = cvt_pk_bf16(b[2], b[3]);
            *(u32x4*)(xb + i * 8) = w;
        }
    }
}

__device__ void ln_phase(int wsg, float* io, const float* g, const float* b, bf16_t* ob, float pre) {
    const int t_ = otid(wsg); const int lane = t_ & 63, wv = blockIdx.x * 8 + (t_ >> 6), nw = gridDim.x * 8;
    f32x4 gv[4], bv[4];
#pragma unroll
    for (int i = 0; i < 4; ++i) { gv[i] = *(const f32x4*)(g + i * 256 + lane * 4); bv[i] = *(const f32x4*)(b + i * 256 + lane * 4); }
    for (int row = wv; row < T_TOK; row += nw) {
        float* rp = io + (size_t)row * DM + lane * 4;
        f32x4 v[4]; float s = 0.f;
#pragma unroll
        for (int i = 0; i < 4; ++i) { v[i] = *(const f32x4*)(rp + i * 256) * pre; s += v[i][0] + v[i][1] + v[i][2] + v[i][3]; }
#pragma unroll
        for (int o = 32; o > 0; o >>= 1) s += shx(s, lane, o);
        const float mu = s * (1.0f / DM);
        float q = 0.f;
#pragma unroll
        for (int i = 0; i < 4; ++i) { v[i] = v[i] - mu; q += v[i][0] * v[i][0] + v[i][1] * v[i][1] + v[i][2] * v[i][2] + v[i][3] * v[i][3]; }
#pragma unroll
        for (int o = 32; o > 0; o >>= 1) q += shx(q, lane, o);
        const float rs = rsqrtf(q * (1.0f / DM) + 1e-5f);
#pragma unroll
        for (int i = 0; i < 4; ++i) {
            const f32x4 y = v[i] * rs * gv[i] + bv[i];
            *(f32x4*)(rp + i * 256) = y;
            if (ob) { u32x2 w; w.x = cvt_pk_bf16(y[0], y[1]); w.y = cvt_pk_bf16(y[2], y[3]); *(u32x2*)(ob + (size_t)row * DM + i * 256 + lane * 4) = w; }
        }
    }
}

__device__ void ln_stats_phase(int wsg, const float* zin, const float* g, const float* b, bf16_t* ob, float* stat) {
    const int t_ = otid(wsg); const int lane = t_ & 63, wv = blockIdx.x * 8 + (t_ >> 6), nw = gridDim.x * 8;
    f32x4 gv[4], bv[4];
#pragma unroll
    for (int i = 0; i < 4; ++i) { gv[i] = *(const f32x4*)(g + i * 256 + lane * 4); bv[i] = *(const f32x4*)(b + i * 256 + lane * 4); }
    for (int row = wv; row < T_TOK; row += nw) {
        const float* rp = zin + (size_t)row * DM + lane * 4;
        f32x4 v[4]; float s = 0.f;
#pragma unroll
        for (int i = 0; i < 4; ++i) { v[i] = *(const f32x4*)(rp + i * 256); s += v[i][0] + v[i][1] + v[i][2] + v[i][3]; }
#pragma unroll
        for (int o = 32; o > 0; o >>= 1) s += shx(s, lane, o);
        const float mu = s * (1.0f / DM);
        float q = 0.f;
#pragma unroll
        for (int i = 0; i < 4; ++i) { v[i] = v[i] - mu; q += v[i][0] * v[i][0] + v[i][1] * v[i][1] + v[i][2] * v[i][2] + v[i][3] * v[i][3]; }
#pragma unroll
        for (int o = 32; o > 0; o >>= 1) q += shx(q, lane, o);
        const float rs = rsqrtf(q * (1.0f / DM) + 1e-5f);
        if (lane == 0) { stat[2 * row] = mu; stat[2 * row + 1] = rs; }
#pragma unroll
        for (int i = 0; i < 4; ++i) {
            const f32x4 y = v[i] * rs * gv[i] + bv[i];
            u32x2 w; w.x = cvt_pk_bf16(y[0], y[1]); w.y = cvt_pk_bf16(y[2], y[3]); *(u32x2*)(ob + (size_t)row * DM + i * 256 + lane * 4) = w;
        }
    }
}

__device__ void lnz_phase(int wsg, const bf16_t* zin, const float* g, const float* b, bf16_t* ob, float* of, float* stat) {
    const int t_ = otid(wsg); const int lane = t_ & 63, wv = blockIdx.x * 8 + (t_ >> 6), nw = gridDim.x * 8;
    f32x4 gv[4], bv[4];
#pragma unroll
    for (int i = 0; i < 4; ++i) { gv[i] = *(const f32x4*)(g + i * 256 + lane * 4); bv[i] = *(const f32x4*)(b + i * 256 + lane * 4); }
    for (int row = wv; row < T_TOK; row += nw) {
        const bf16_t* rp = zin + (size_t)row * DM + lane * 4;
        f32x4 v[4]; float s = 0.f;
#pragma unroll
        for (int i = 0; i < 4; ++i) { const u32x2 w = *(const u32x2*)(rp + i * 256); v[i] = (f32x4){bflo(w.x), bfhi(w.x), bflo(w.y), bfhi(w.y)}; s += v[i][0] + v[i][1] + v[i][2] + v[i][3]; }
#pragma unroll
        for (int o = 32; o > 0; o >>= 1) s += shx(s, lane, o);
        const float mu = s * (1.0f / DM);
        float q = 0.f;
#pragma unroll
        for (int i = 0; i < 4; ++i) { v[i] = v[i] - mu; q += v[i][0] * v[i][0] + v[i][1] * v[i][1] + v[i][2] * v[i][2] + v[i][3] * v[i][3]; }
#pragma unroll
        for (int o = 32; o > 0; o >>= 1) q += shx(q, lane, o);
        const float rs = rsqrtf(q * (1.0f / DM) + 1e-5f);
        if (stat && lane == 0) { stat[2 * row] = mu; stat[2 * row + 1] = rs; }
#pragma unroll
        for (int i = 0; i < 4; ++i) {
            const f32x4 y = v[i] * rs * gv[i] + bv[i];
            if (of) __builtin_nontemporal_store(y, (f32x4*)(of + (size_t)row * DM + i * 256 + lane * 4));
            if (ob) { u32x2 w; w.x = cvt_pk_bf16(y[0], y[1]); w.y = cvt_pk_bf16(y[2], y[3]); *(u32x2*)(ob + (size_t)row * DM + i * 256 + lane * 4) = w; }
        }
    }
}

__device__ void f32_to_bf16_phase(int wsg, const float* src, bf16_t* dst, long n8) {
    const long gstride = (long)gridDim.x * 512;
    for (long i = (long)blockIdx.x * 512 + otid(wsg); i < n8; i += gstride) {
        const f32x4 a = *(const f32x4*)(src + i * 8), b = *(const f32x4*)(src + i * 8 + 4);
        u32x4 w; w.x = cvt_pk_bf16(a[0], a[1]); w.y = cvt_pk_bf16(a[2], a[3]); w.z = cvt_pk_bf16(b[0], b[1]); w.w = cvt_pk_bf16(b[2], b[3]);
        *(u32x4*)(dst + i * 8) = w;
    }
}

__device__ __forceinline__ float wave_sum(float s, int lane) {
#pragma unroll
    for (int o = 32; o > 0; o >>= 1) s += shx(s, lane, o);
    return s;
}
__device__ __forceinline__ void unpack4(u32x2 w, float (&x)[4]) { x[0] = bflo(w.x); x[1] = bfhi(w.x); x[2] = bflo(w.y); x[3] = bfhi(w.y); }
__device__ __forceinline__ u32x2 pack4(const float (&x)[4]) { u32x2 w; w.x = cvt_pk_bf16(x[0], x[1]); w.y = cvt_pk_bf16(x[2], x[3]); return w; }

__device__ void prep_phase(int wsg, const Params& p) {
    unsigned char* ws = p.ws;
    const bf16_t* __restrict__ PROJ = (const bf16_t*)(ws + OFF_R3);
    bf16_t* __restrict__ LIN = (bf16_t*)(ws + OFF_R1); bf16_t* __restrict__ QN = (bf16_t*)(ws + OFF_R1 + 48 * MiB); bf16_t* __restrict__ KVN = (bf16_t*)(ws + OFF_R1 + 96 * MiB);
    bf16_t* __restrict__ KPE = (bf16_t*)(ws + OFF_R4 + 128 * MiB);
    const float* mu = p.in[I_MU]; const float* qg = p.in[I_QNG]; const float* kvg = p.in[I_KVNG]; const float* rope = (const float*)(ws + OFF_ROPE);
    const int t_ = otid(wsg); const int lane = t_ & 63, wv = blockIdx.x * 8 + (t_ >> 6), nw = gridDim.x * 8;
#pragma unroll 2
    for (int row = wv; row < T_TOK; row += nw) {
        const bf16_t* P = PROJ + (size_t)row * PROJ_LD; const int pos = row & (SEQ - 1); const bool hp = pos != 0; const bf16_t* Pp = P - PROJ_LD;
#pragma unroll
        for (int it = 0; it < 2; ++it) {
            const int idx = it * 256 + lane * 4;
            if (idx < 288) {
                float c[4], pv[4] = {0.f, 0.f, 0.f, 0.f}; unpack4(*(const u32x2*)(P + 1536 + idx), c);
                if (hp) unpack4(*(const u32x2*)(Pp + 1536 + idx), pv);
                const f32x4 m4 = *(const f32x4*)(mu + 1536 + idx);
                float o[4];
#pragma unroll
                for (int e = 0; e < 4; ++e) { const float x = c[e] + m4[e] * (pv[e] - c[e]); o[e] = idx < 64 ? tanhf(x) : (idx < 128 ? x : __builtin_amdgcn_rcpf(1.0f + __expf(-x))); }
                *(u32x2*)(LIN + (size_t)row * 384 + idx) = pack4(o);
            } else if (idx < 384) { u32x2 z; z.x = 0u; z.y = 0u; *(u32x2*)(LIN + (size_t)row * 384 + idx) = z; }
        }
        {
            float a[4], b[4] = {0.f, 0.f, 0.f, 0.f}; unpack4(*(const u32x2*)(P + 1824 + lane * 4), a);
            if (lane < 32) unpack4(*(const u32x2*)(P + 1824 + 256 + lane * 4), b);
            float ss = a[0] * a[0] + a[1] * a[1] + a[2] * a[2] + a[3] * a[3] + b[0] * b[0] + b[1] * b[1] + b[2] * b[2] + b[3] * b[3];
            ss = wave_sum(ss, lane);
            const float r = rsqrtf(ss * (1.0f / 384.0f) + 1e-6f);
            const f32x4 g0 = *(const f32x4*)(qg + lane * 4);
            float o[4];
#pragma unroll
            for (int e = 0; e < 4; ++e) o[e] = a[e] * r * g0[e];
            *(u32x2*)(QN + (size_t)row * 384 + lane * 4) = pack4(o);
            if (lane < 32) { const f32x4 g1 = *(const f32x4*)(qg + 256 + lane * 4);
#pragma unroll
                for (int e = 0; e < 4; ++e) o[e] = b[e] * r * g1[e];
                *(u32x2*)(QN + (size_t)row * 384 + 256 + lane * 4) = pack4(o); }
        }
        {
            float a[4]; unpack4(*(const u32x2*)(P + 2208 + lane * 4), a);
            float ss = a[0] * a[0] + a[1] * a[1] + a[2] * a[2] + a[3] * a[3];
            ss = wave_sum(ss, lane);
            const float r = rsqrtf(ss * (1.0f / 256.0f) + 1e-6f);
            const f32x4 g0 = *(const f32x4*)(kvg + lane * 4);
            float o[4];
#pragma unroll
            for (int e = 0; e < 4; ++e) o[e] = a[e] * r * g0[e];
            *(u32x2*)(KVN + (size_t)row * 256 + lane * 4) = pack4(o);
        }
        if (lane < 16) {
            const float x1 = bf2f(P[2464 + lane]), x2 = bf2f(P[2464 + 16 + lane]);
            const float cs = rope[pos * 16 + lane], sn = rope[8192 * 16 + pos * 16 + lane];
            *(unsigned*)(KPE + (size_t)row * 32 + 2 * lane) = cvt_pk_bf16(x1 * cs - x2 * sn, x2 * cs + x1 * sn);
        }
    }
}

__device__ void attn_phase(int wsg, LAS unsigned char* lds, const bf16_t* Q, const bf16_t* KN, const bf16_t* KPE, const bf16_t* VT, bf16_t* YM, unsigned* counter, const float* rope) {
    constexpr int KSTR = 208, VSTR = 136, KBUF = 64 * KSTR, VBUF = 64 * VSTR, V_OFF0 = 2 * KBUF, ITEM_OFF = V_OFF0 + 3 * VBUF;
    const int tid_ = otid(wsg);
    const int tid = tid_, lane = tid & 63, wid = tid >> 6, l31 = lane & 31, half = lane >> 5;
    volatile LAS int* s_item = (volatile LAS int*)(lds + ITEM_OFF);
    const int xcd = (int)(__builtin_amdgcn_s_getreg((3 << 11) | 20) & 7u);
    for (;;) {
        __syncthreads();
        if (tid == 0) {
            int it = -1;
            for (int s = 0; s < 8 && it < 0; ++s) { const int q = (xcd + s) & 7; const unsigned i = atomicAdd(counter + q * 16, 1u); if (i < 256u) it = q * 256 + (int)i; }
            *s_item = it;
        }
        __syncthreads();
        const int item = *s_item;
        if (item < 0) break;
        const int qi = item & 255, bh = (item >> 8) + 8 * (qi & 7), qb = 31 - (qi >> 3), b = bh >> 3, h = bh & 7;
        const size_t tb = (size_t)b * SEQ;
        const int qrow = qb * 256 + wid * 32 + l31;
        bf16x8 qf[6];
#pragma unroll
        for (int ks = 0; ks < 6; ++ks) qf[ks] = *(const bf16x8*)(Q + (tb + qrow) * 768 + h * 96 + ks * 16 + half * 8);
#pragma unroll
        for (int ks = 4; ks < 6; ++ks) {
            const int p0 = (ks - 4) * 8 + half * 4;
            const f32x4 cs = *(const f32x4*)(rope + qrow * 16 + p0), sn = *(const f32x4*)(rope + 8192 * 16 + qrow * 16 + p0);
            const u32x4 w = __builtin_bit_cast(u32x4, qf[ks]);
            u32x4 o;
            { const float x1 = bflo(w.x), x2 = bfhi(w.x); o.x = cvt_pk_bf16(x1 * cs[0] - x2 * sn[0], x2 * cs[0] + x1 * sn[0]); }
            { const float x1 = bflo(w.y), x2 = bfhi(w.y); o.y = cvt_pk_bf16(x1 * cs[1] - x2 * sn[1], x2 * cs[1] + x1 * sn[1]); }
            { const float x1 = bflo(w.z), x2 = bfhi(w.z); o.z = cvt_pk_bf16(x1 * cs[2] - x2 * sn[2], x2 * cs[2] + x1 * sn[2]); }
            { const float x1 = bflo(w.w), x2 = bfhi(w.w); o.w = cvt_pk_bf16(x1 * cs[3] - x2 * sn[3], x2 * cs[3] + x1 * sn[3]); }
            qf[ks] = __builtin_bit_cast(bf16x8, o);
        }
        const int ntiles = 4 * qb + 4, jmax = 4 * qb + (wid >> 1);
        const int skey = tid >> 3, sseg = tid & 7;
        const bf16_t* gK = KN + (tb + skey) * 512 + h * 64 + sseg * 8;
        const bf16_t* gP = KPE + (tb + ((tid & 255) >> 2)) * 32 + (tid & 3) * 8;
        const bf16_t* gV = VT + ((size_t)((b * 8 + h) * 64 + skey)) * SEQ + sseg * 8;
        const unsigned lK = skey * KSTR + sseg * 16, lP = (tid >> 2) * KSTR + 128 + (tid & 3) * 16, lV = V_OFF0 + skey * VSTR + sseg * 16;
        u32x4 rK = *(const u32x4*)gK, rP = (u32x4){0u, 0u, 0u, 0u}, rV = *(const u32x4*)gV;
        rP = *(const u32x4*)gP;
        *(LAS u32x4*)(lds + lK) = rK; if (tid < 256) *(LAS u32x4*)(lds + lP) = rP; *(LAS u32x2*)(lds + lV) = (u32x2){rV.x, rV.y}; *(LAS u32x2*)(lds + lV + 8) = (u32x2){rV.z, rV.w};
        rK = *(const u32x4*)(gK + (size_t)64 * 512); rV = *(const u32x4*)(gV + 64); rP = *(const u32x4*)(gP + (size_t)64 * 32);
        u32x4 nK = rK, nP = rP, nV = rV;
        __syncthreads();
        f32x16 ot[2], st[2];
#pragma unroll
        for (int i = 0; i < 16; ++i) { ot[0][i] = 0.f; ot[1][i] = 0.f; st[0][i] = 0.f; st[1][i] = 0.f; }
        float mrun = 0.f, lrun = 0.f;
        auto QK = [&](int jt) {
            const float negm = -mrun;
#pragma unroll
            for (int i = 0; i < 16; ++i) { st[0][i] = negm; st[1][i] = negm; }
            const LAS unsigned char* kb = lds + (jt & 1) * KBUF + l31 * KSTR + half * 16;
#pragma unroll
            for (int ks = 0; ks < 6; ++ks)
#pragma unroll
                for (int kt = 0; kt < 2; ++kt) {
                    const bf16x8 a = *(const LAS bf16x8*)(kb + kt * 32 * KSTR + ks * 32);
                    st[kt] = __builtin_amdgcn_mfma_f32_32x32x16_bf16(a, qf[ks], st[kt], 0, 0, 0);
                }
        };
        auto SMPV = [&](int jt) {
            float mx = fmaxf(st[0][0], st[1][0]);
#pragma unroll
            for (int i = 1; i < 16; ++i) mx = fmaxf(fmaxf(mx, st[0][i]), st[1][i]);
            mx = fmaxf(mx, shx(mx, lane, 32));
            const bool slow = (jt == 0) || (__builtin_amdgcn_ballot_w64(mx > 8.0f) != 0ull);
            if (slow) {
                const float delta = (jt == 0 || mx > 0.f) ? mx : 0.f;
                const float alpha = __builtin_amdgcn_exp2f(-delta);
                mrun += delta; lrun *= alpha;
#pragma unroll
                for (int i = 0; i < 16; ++i) { ot[0][i] *= alpha; ot[1][i] *= alpha; st[0][i] -= delta; st[1][i] -= delta; }
            }
            float rs = 0.f;
#pragma unroll
            for (int kt = 0; kt < 2; ++kt)
#pragma unroll
                for (int i = 0; i < 16; ++i) { const float pe = __builtin_amdgcn_exp2f(st[kt][i]); st[kt][i] = pe; rs += pe; }
            lrun += rs;
            bf16x8 pf[2][2];
#pragma unroll
            for (int kt = 0; kt < 2; ++kt)
#pragma unroll
                for (int s2 = 0; s2 < 2; ++s2) {
                    u32x4 w; w.x = cvt_pk_bf16(st[kt][8 * s2 + 0], st[kt][8 * s2 + 1]); w.y = cvt_pk_bf16(st[kt][8 * s2 + 2], st[kt][8 * s2 + 3]);
                    w.z = cvt_pk_bf16(st[kt][8 * s2 + 4], st[kt][8 * s2 + 5]); w.w = cvt_pk_bf16(st[kt][8 * s2 + 6], st[kt][8 * s2 + 7]);
                    pf[kt][s2] = __builtin_bit_cast(bf16x8, w);
                }
            __builtin_amdgcn_sched_barrier(0);
            const LAS unsigned char* vb = lds + V_OFF0 + (jt % 3) * VBUF + l31 * VSTR + half * 8;
#pragma unroll
            for (int dvt = 0; dvt < 2; ++dvt)
#pragma unroll
                for (int kt = 0; kt < 2; ++kt)
#pragma unroll
                    for (int s2 = 0; s2 < 2; ++s2) {
                        const LAS unsigned char* vp = vb + dvt * 32 * VSTR + (kt * 32 + s2 * 16) * 2;
                        const u32x2 lo = *(const LAS u32x2*)vp, hi = *(const LAS u32x2*)(vp + 16);
                        u32x4 av; av.x = lo.x; av.y = lo.y; av.z = hi.x; av.w = hi.y;
                        ot[dvt] = __builtin_amdgcn_mfma_f32_32x32x16_bf16(__builtin_bit_cast(bf16x8, av), pf[kt][s2], ot[dvt], 0, 0, 0);
                    }
        };
        const bool late = wid >= 4;
        if (late) __builtin_amdgcn_s_setprio(1);
        auto step = [&](int j, u32x4& aK, u32x4& aP, u32x4& aV, u32x4& bK, u32x4& bP, u32x4& bV) {
            if (j + 2 < ntiles) {
                bK = *(const u32x4*)(gK + (size_t)(j + 2) * 64 * 512); bV = *(const u32x4*)(gV + (j + 2) * 64); bP = *(const u32x4*)(gP + (size_t)(j + 2) * 64 * 32);
            }
            if (!late) {
                if (j < ntiles && j <= jmax) { QK(j); __builtin_amdgcn_sched_barrier(0); SMPV(j); }
            } else {
                if (j >= 1 && j - 1 <= jmax) SMPV(j - 1);
                __builtin_amdgcn_sched_barrier(0);
                if (j < ntiles && j <= jmax) QK(j);
            }
            if (j + 1 < ntiles) {
                const unsigned kofs = (unsigned)((j + 1) & 1) * KBUF, vofs = (unsigned)((j + 1) % 3) * VBUF;
                *(LAS u32x4*)(lds + kofs + lK) = aK; if (tid < 256) *(LAS u32x4*)(lds + kofs + lP) = aP; *(LAS u32x2*)(lds + vofs + lV) = (u32x2){aV.x, aV.y}; *(LAS u32x2*)(lds + vofs + lV + 8) = (u32x2){aV.z, aV.w};
            }
            __syncthreads();
        };
        for (int j = 0; j <= ntiles; j += 2) {
            step(j, rK, rP, rV, nK, nP, nV);
            if (j + 1 <= ntiles) step(j + 1, nK, nP, nV, rK, rP, rV);
        }
        __builtin_amdgcn_s_setprio(0);
        lrun += shx(lrun, lane, 32);
        const float inv = 1.0f / lrun;
        bf16_t* op = YM + (tb + qrow) * 512 + h * 64 + half * 4;
#pragma unroll
        for (int dvt = 0; dvt < 2; ++dvt)
#pragma unroll
            for (int g = 0; g < 4; ++g) {
                u32x2 w; w.x = cvt_pk_bf16(ot[dvt][4 * g] * inv, ot[dvt][4 * g + 1] * inv); w.y = cvt_pk_bf16(ot[dvt][4 * g + 2] * inv, ot[dvt][4 * g + 3] * inv);
                *(u32x2*)(op + dvt * 32 + g * 8) = w;
            }
    }
}

constexpr int MS = 144;
constexpr int MB = 64 * MS;
constexpr int SC_KT = 0, SC_BT = MB, SC_QK = 2 * MB, SC_RT = 3 * MB, SC_KH = 4 * MB, SC_BH = 5 * MB, SC_VM = 6 * MB, SC_S0 = 7 * MB,
              SC_MK = 8 * MB, SC_AK = 9 * MB, SC_AB = 10 * MB, SC_RHS = 11 * MB, SC_NT = 12 * MB  , SC_MISC = SC_NT + 64 * 68 * 4;
constexpr int SC_TT = SC_KT, SC_UN = SC_MK, SC_YF = SC_NT;
constexpr int SS = 80;
constexpr int SC_N12 = SC_BT, SC_XT = SC_BT + 32 * SS, SC_T11 = SC_BT + 64 * SS;
static_assert(SC_MISC + 1024 <= LDS_MAIN, "scan LDS overflow");

template <int KS, bool SWA = false, bool SWB = false>
__device__ __forceinline__ f32x16 mm_tile(f32x16 acc, const LAS unsigned char* A, int arow0, const LAS unsigned char* B, int brow0, int l31, int half) {
    const int ra = arow0 + l31, rb = brow0 + l31;
    const LAS unsigned char* ap = A + ra * MS;
    const LAS unsigned char* bp = B + rb * MS;
    const int sa = SWA ? ((ra >> 3) & 7) : 0, sb = SWB ? ((rb >> 3) & 7) : 0;
#pragma unroll
    for (int ks = 0; ks < KS; ++ks) {
        const int q = ks * 2 + half;
        acc = __builtin_amdgcn_mfma_f32_32x32x16_bf16(*(const LAS bf16x8*)(ap + ((q ^ sa) << 4)), *(const LAS bf16x8*)(bp + ((q ^ sb) << 4)), acc, 0, 0, 0);
    }
    return acc;
}
__device__ __forceinline__ void store_tile_nm(LAS unsigned char* D, int nrow0, int mcol0, const f32x16& acc, int l31, int half, float sc, int stride = MS) {
    LAS unsigned char* dp = D + (nrow0 + l31) * stride + (mcol0 + half * 4) * 2;
#pragma unroll
    for (int g = 0; g < 4; ++g) { u32x2 w; w.x = cvt_pk_bf16(acc[4 * g] * sc, acc[4 * g + 1] * sc); w.y = cvt_pk_bf16(acc[4 * g + 2] * sc, acc[4 * g + 3] * sc); *(LAS u32x2*)(dp + g * 16) = w; }
}
__device__ __forceinline__ f32x16 zero16() { f32x16 z;
#pragma unroll
    for (int i = 0; i < 16; ++i) z[i] = 0.f; return z; }

__device__ void scan_chain(int wsg, LAS unsigned char* lds, const Params& p, int chain) {
    unsigned char* ws = p.ws;
    const bf16_t* PROJ = (const bf16_t*)(ws + OFF_R3);
    const unsigned short* WAG = (const unsigned short*)(ws + OFF_R2);
    bf16_t* YR = (bf16_t*)(ws + OFF_R1);
    const int tid0 = otid(wsg), wid = __builtin_amdgcn_readfirstlane(tid0 >> 6);
    const int b = chain >> 3, h = chain & 7;
    for (int i = tid0; i < MB / 4; i += 512) *(LAS unsigned*)(lds + SC_S0 + i * 4) = 0u;
    f32x16 st = zero16();
    const size_t tok0 = (size_t)b * SEQ;
    u32x4 cr, ck, cv, pr, pk, pv, ce, ca, cg;
    auto prefetch = [&](int c, int tl, int hc) {
        const size_t tok = tok0 + (size_t)c * 64 + tl;
        const bf16_t* P = PROJ + tok * PROJ_LD + hc;
        cr = *(const u32x4*)P; ck = *(const u32x4*)(P + 512); cv = *(const u32x4*)(P + 1024);
        if (c * 64 + tl > 0) { pr = *(const u32x4*)(P - PROJ_LD); pk = *(const u32x4*)(P - PROJ_LD + 512); pv = *(const u32x4*)(P - PROJ_LD + 1024); }
        else { pr = (u32x4){0u, 0u, 0u, 0u}; pk = pr; pv = pr; }
        const unsigned short* W = WAG + tok * 1536 + hc;
        ce = *(const u32x4*)W; ca = *(const u32x4*)(W + 512); cg = *(const u32x4*)(W + 1024);
    };
    prefetch(0, tid0 >> 3, h * 64 + (tid0 & 7) * 8);
    LAS float* NT = (LAS float*)(lds + SC_NT);
    LAS float* WC = (LAS float*)(lds + SC_MISC);
#pragma unroll 1
    for (int c = 0; c < SEQ / 64; ++c) {
        int tid = tid0; asm volatile("" : "+v"(tid));
        const int lane = tid & 63, l31 = lane & 31, half = lane >> 5;
        const int tl = tid >> 3, kseg = tid & 7, k0 = kseg * 8, hc = h * 64 + k0;
        float r_[8], k_[8], v_[8], e_[8], a_[8], g_[8];
        {
            float mu_r[8], mu_k[8], mu_v[8];
            { const f32x4 a0 = *(const f32x4*)(p.in[I_MU] + hc), a1 = *(const f32x4*)(p.in[I_MU] + hc + 4), b0 = *(const f32x4*)(p.in[I_MU] + 512 + hc), b1 = *(const f32x4*)(p.in[I_MU] + 512 + hc + 4),
                          c0 = *(const f32x4*)(p.in[I_MU] + 1024 + hc), c1 = *(const f32x4*)(p.in[I_MU] + 1024 + hc + 4);
#pragma unroll
              for (int e = 0; e < 4; ++e) { mu_r[e] = a0[e]; mu_r[4 + e] = a1[e]; mu_k[e] = b0[e]; mu_k[4 + e] = b1[e]; mu_v[e] = c0[e]; mu_v[4 + e] = c1[e]; } }
            const unsigned wr_[4] = {cr.x, cr.y, cr.z, cr.w}, wk_[4] = {ck.x, ck.y, ck.z, ck.w}, wv_[4] = {cv.x, cv.y, cv.z, cv.w};
            const unsigned xr_[4] = {pr.x, pr.y, pr.z, pr.w}, xk_[4] = {pk.x, pk.y, pk.z, pk.w}, xv_[4] = {pv.x, pv.y, pv.z, pv.w};
            const unsigned we_[4] = {ce.x, ce.y, ce.z, ce.w}, wa_[4] = {ca.x, ca.y, ca.z, ca.w}, wg_[4] = {cg.x, cg.y, cg.z, cg.w};
#pragma unroll
            for (int q = 0; q < 4; ++q) {
                float c0 = bflo(wr_[q]), c1 = bfhi(wr_[q]); r_[2 * q] = c0 + mu_r[2 * q] * (bflo(xr_[q]) - c0); r_[2 * q + 1] = c1 + mu_r[2 * q + 1] * (bfhi(xr_[q]) - c1);
                c0 = bflo(wk_[q]); c1 = bfhi(wk_[q]); k_[2 * q] = c0 + mu_k[2 * q] * (bflo(xk_[q]) - c0); k_[2 * q + 1] = c1 + mu_k[2 * q + 1] * (bfhi(xk_[q]) - c1);
                c0 = bflo(wv_[q]); c1 = bfhi(wv_[q]); v_[2 * q] = c0 + mu_v[2 * q] * (bflo(xv_[q]) - c0); v_[2 * q + 1] = c1 + mu_v[2 * q + 1] * (bfhi(xv_[q]) - c1);
                e_[2 * q] = f16lo(we_[q]); e_[2 * q + 1] = f16hi(we_[q]); a_[2 * q] = f16lo(wa_[q]); a_[2 * q + 1] = f16hi(wa_[q]); g_[2 * q] = f16lo(wg_[q]); g_[2 * q + 1] = f16hi(wg_[q]);
            }
        }
        if (c + 1 < SEQ / 64) prefetch(c + 1, tl, hc);
        float kk_[8], bb_[8], bonus = 0.f;
        {
            float kkc[8], kac[8], rkc[8];
            { const f32x4 a0 = *(const f32x4*)(p.in[I_KK] + hc), a1 = *(const f32x4*)(p.in[I_KK] + hc + 4), b0 = *(const f32x4*)(p.in[I_KA] + hc), b1 = *(const f32x4*)(p.in[I_KA] + hc + 4),
                          c0 = *(const f32x4*)(p.in[I_RK] + hc), c1 = *(const f32x4*)(p.in[I_RK] + hc + 4);
#pragma unroll
              for (int e = 0; e < 4; ++e) { kkc[e] = a0[e]; kkc[4 + e] = a1[e]; kac[e] = b0[e]; kac[4 + e] = b1[e]; rkc[e] = c0[e]; rkc[4 + e] = c1[e]; } }
            float ss = 0.f;
#pragma unroll
            for (int e = 0; e < 8; ++e) { kk_[e] = k_[e] * kkc[e]; ss += kk_[e] * kk_[e]; }
            ss += shx(ss, lane, 1); ss += shx(ss, lane, 2); ss += shx(ss, lane, 4);
            const float rn = rsqrtf(fmaxf(ss, 1e-24f));
#pragma unroll
            for (int e = 0; e < 8; ++e) { kk_[e] *= rn; k_[e] = k_[e] * (1.0f + (a_[e] - 1.0f) * kac[e]); bb_[e] = kk_[e] * a_[e]; bonus += r_[e] * k_[e] * rkc[e]; }
            bonus += shx(bonus, lane, 1); bonus += shx(bonus, lane, 2); bonus += shx(bonus, lane, 4);
        }
        float L[8], Lm[8], LC[8];
        {
#pragma unroll
            for (int e = 0; e < 8; ++e) L[e] = -e_[e];
            const int jj = lane >> 3;
#pragma unroll
            for (int d = 1; d < 8; d <<= 1) {
#pragma unroll
                for (int e = 0; e < 8; ++e) { const float y = __int_as_float(__builtin_amdgcn_ds_bpermute((lane - 8 * d) << 2, __float_as_int(L[e]))); L[e] += (jj >= d) ? y : 0.f; }
            }
            LAS float* TOT = (LAS float*)(lds + SC_RHS);
            if (jj == 7) { *(LAS f32x4*)(TOT + wid * 64 + k0) = (f32x4){L[0], L[1], L[2], L[3]}; *(LAS f32x4*)(TOT + wid * 64 + k0 + 4) = (f32x4){L[4], L[5], L[6], L[7]}; }
            __syncthreads();
            float off[8];
#pragma unroll
            for (int e = 0; e < 8; ++e) { off[e] = 0.f; LC[e] = 0.f; }
#pragma unroll
            for (int w = 0; w < 8; ++w) {
                const f32x4 t0 = *(const LAS f32x4*)(TOT + w * 64 + k0), t1 = *(const LAS f32x4*)(TOT + w * 64 + k0 + 4);
                const float tv[8] = {t0[0], t0[1], t0[2], t0[3], t1[0], t1[1], t1[2], t1[3]};
#pragma unroll
                for (int e = 0; e < 8; ++e) { LC[e] += tv[e]; off[e] += (w < wid) ? tv[e] : 0.f; }
            }
#pragma unroll
            for (int e = 0; e < 8; ++e) { L[e] += off[e]; Lm[e] = L[e] + e_[e]; }
            if (tl == 63) { *(LAS f32x4*)(WC + k0) = (f32x4){__expf(LC[0]), __expf(LC[1]), __expf(LC[2]), __expf(LC[3])}; *(LAS f32x4*)(WC + k0 + 4) = (f32x4){__expf(LC[4]), __expf(LC[5]), __expf(LC[6]), __expf(LC[7])}; }
        }
        {
            float qk[8], rt[8], kt[8], bt[8], kh[8], bh[8];
#pragma unroll
            for (int e = 0; e < 8; ++e) {
                const float el = __expf(L[e]), elm = __expf(Lm[e]), ei = __expf(-L[e]), ec = __expf(LC[e] - L[e]);
                qk[e] = kk_[e] * elm; rt[e] = r_[e] * el; kt[e] = k_[e] * ei; bt[e] = bb_[e] * ei; kh[e] = k_[e] * ec; bh[e] = bb_[e] * ec;
            }
            u32x4 w;
            w.x = cvt_pk_bf16(qk[0], qk[1]); w.y = cvt_pk_bf16(qk[2], qk[3]); w.z = cvt_pk_bf16(qk[4], qk[5]); w.w = cvt_pk_bf16(qk[6], qk[7]); *(LAS u32x4*)(lds + SC_QK + tl * MS + k0 * 2) = w;
            w.x = cvt_pk_bf16(rt[0], rt[1]); w.y = cvt_pk_bf16(rt[2], rt[3]); w.z = cvt_pk_bf16(rt[4], rt[5]); w.w = cvt_pk_bf16(rt[6], rt[7]); *(LAS u32x4*)(lds + SC_RT + tl * MS + k0 * 2) = w;
            w.x = cvt_pk_bf16(kt[0], kt[1]); w.y = cvt_pk_bf16(kt[2], kt[3]); w.z = cvt_pk_bf16(kt[4], kt[5]); w.w = cvt_pk_bf16(kt[6], kt[7]); *(LAS u32x4*)(lds + SC_KT + tl * MS + k0 * 2) = w;
            w.x = cvt_pk_bf16(bt[0], bt[1]); w.y = cvt_pk_bf16(bt[2], bt[3]); w.z = cvt_pk_bf16(bt[4], bt[5]); w.w = cvt_pk_bf16(bt[6], bt[7]); *(LAS u32x4*)(lds + SC_BT + tl * MS + k0 * 2) = w;
#pragma unroll
            for (int e = 0; e < 8; ++e) {
                const int toff = (k0 + e) * MS + ((wid ^ kseg) << 4) + (tl & 7) * 2;
                *(LAS bf16_t*)(lds + SC_KH + toff) = (bf16_t)(cvt_pk_bf16(kh[e], 0.f) & 0xffffu);
                *(LAS bf16_t*)(lds + SC_BH + toff) = (bf16_t)(cvt_pk_bf16(bh[e], 0.f) & 0xffffu);
                *(LAS bf16_t*)(lds + SC_VM + toff) = (bf16_t)(cvt_pk_bf16(v_[e], 0.f) & 0xffffu);
            }
        }
        __syncthreads();
#pragma unroll
        for (int q = 0; q < 2; ++q) {
            const int tile = wid * 2 + q, mi = tile >> 2, ni = tile & 3;
            const int ib = (mi & 1) * 32, tb = (ni & 1) * 32;
            if (ib > tb) {
                if (!(mi >= 2 && ni < 2)) { LAS unsigned char* D = lds + (mi < 2 ? (ni < 2 ? SC_MK : SC_AK) : SC_AB); store_tile_nm(D, tb, ib, zero16(), l31, half, 0.f); }
                else {
#pragma unroll
                    for (int i = 0; i < 16; ++i) NT[(tb + l31) * 68 + ib + 8 * (i >> 2) + 4 * half + (i & 3)] = 0.f; }
                continue;
            }
            f32x16 acc = mm_tile<4>(zero16(), lds + SC_KT, mi * 32, lds + SC_QK, ni * 32, l31, half);
            const bool strict = (ni < 2);
#pragma unroll
            for (int i = 0; i < 16; ++i) { const int ii = ib + 8 * (i >> 2) + 4 * half + (i & 3), tt = tb + l31; const bool keep = strict ? (ii < tt) : (ii <= tt); acc[i] = keep ? acc[i] : 0.f; }
            if (mi >= 2 && ni < 2) {
#pragma unroll
                for (int i = 0; i < 16; ++i) NT[(tb + l31) * 68 + ib + 8 * (i >> 2) + 4 * half + (i & 3)] = acc[i];
            } else { LAS unsigned char* D = lds + (mi < 2 ? (ni < 2 ? SC_MK : SC_AK) : SC_AB); store_tile_nm(D, tb, ib, acc, l31, half, 1.0f); }
        }
        __syncthreads();
        if (wid == 0) {
            const int base = half * 32;
            float Tj[32];
            f32x4 cur[8], nxt[8];
#pragma unroll
            for (int q = 0; q < 8; ++q) { cur[q] = (f32x4){0.f, 0.f, 0.f, 0.f}; nxt[q] = cur[q]; }
#pragma unroll
            for (int tt = 0; tt < 32; ++tt) {
                if (tt + 1 < 32) {
#pragma unroll
                    for (int i4 = 0; i4 < (tt + 1 + 3) / 4; ++i4) nxt[i4] = *(const LAS f32x4*)(NT + (base + tt + 1) * 68 + base + i4 * 4);
                }
                __builtin_amdgcn_sched_barrier(0);
                float s0 = (l31 == tt) ? 1.0f : 0.0f, s1 = 0.f;
#pragma unroll
                for (int ii = 0; ii < tt; ++ii) { if (ii & 1) s1 -= Tj[ii] * cur[ii >> 2][ii & 3]; else s0 -= Tj[ii] * cur[ii >> 2][ii & 3]; }
                Tj[tt] = s0 + s1;
                __builtin_amdgcn_sched_barrier(0);
#pragma unroll
                for (int q = 0; q < 8; ++q) cur[q] = nxt[q];
            }
#pragma unroll
            for (int tt = 0; tt < 32; ++tt) *(LAS bf16_t*)(lds + SC_TT + (base + tt) * MS + (base + l31) * 2) = (bf16_t)(cvt_pk_bf16(Tj[tt], 0.f) & 0xffffu);
            {
                LAS unsigned char* zp = lds + SC_TT + l31 * MS + 64 + half * 32;
                *(LAS u32x4*)zp = (u32x4){0u, 0u, 0u, 0u}; *(LAS u32x4*)(zp + 16) = (u32x4){0u, 0u, 0u, 0u};
            }
            if (half == 0) {
#pragma unroll
                for (int q = 0; q < 4; ++q) { u32x4 w; w.x = cvt_pk_bf16(Tj[8 * q], Tj[8 * q + 1]); w.y = cvt_pk_bf16(Tj[8 * q + 2], Tj[8 * q + 3]); w.z = cvt_pk_bf16(Tj[8 * q + 4], Tj[8 * q + 5]); w.w = cvt_pk_bf16(Tj[8 * q + 6], Tj[8 * q + 7]);
                    *(LAS u32x4*)(lds + SC_T11 + l31 * SS + q * 16) = w; }
            }
            {
                float nv[16];
#pragma unroll
                for (int s = 0; s < 16; ++s) nv[s] = NT[(32 + half * 16 + s) * 68 + l31];
                u32x4 w; w.x = cvt_pk_bf16(nv[0], nv[1]); w.y = cvt_pk_bf16(nv[2], nv[3]); w.z = cvt_pk_bf16(nv[4], nv[5]); w.w = cvt_pk_bf16(nv[6], nv[7]);
                *(LAS u32x4*)(lds + SC_N12 + l31 * SS + half * 32) = w;
                w.x = cvt_pk_bf16(nv[8], nv[9]); w.y = cvt_pk_bf16(nv[10], nv[11]); w.z = cvt_pk_bf16(nv[12], nv[13]); w.w = cvt_pk_bf16(nv[14], nv[15]);
                *(LAS u32x4*)(lds + SC_N12 + l31 * SS + half * 32 + 16) = w;
            }
            __builtin_amdgcn_fence(__ATOMIC_RELEASE, "workgroup"); __builtin_amdgcn_wave_barrier();
            {
                f32x16 x = zero16();
                const LAS unsigned char* ap = lds + SC_N12 + l31 * SS + half * 16;
                const LAS unsigned char* bp = lds + SC_TT + (32 + l31) * MS + (32 + half * 8) * 2;
#pragma unroll
                for (int ks = 0; ks < 2; ++ks) x = __builtin_amdgcn_mfma_f32_32x32x16_bf16(*(const LAS bf16x8*)(ap + ks * 32), *(const LAS bf16x8*)(bp + ks * 32), x, 0, 0, 0);
                store_tile_nm(lds + SC_XT, 0, 0, x, l31, half, 1.0f, SS);
            }
            __builtin_amdgcn_fence(__ATOMIC_RELEASE, "workgroup"); __builtin_amdgcn_wave_barrier();
            {
                f32x16 x = zero16();
                const LAS unsigned char* ap = lds + SC_T11 + l31 * SS + half * 16;
                const LAS unsigned char* bp = lds + SC_XT + l31 * SS + half * 16;
#pragma unroll
                for (int ks = 0; ks < 2; ++ks) x = __builtin_amdgcn_mfma_f32_32x32x16_bf16(*(const LAS bf16x8*)(ap + ks * 32), *(const LAS bf16x8*)(bp + ks * 32), x, 0, 0, 0);
                store_tile_nm(lds + SC_TT, 32, 0, x, l31, half, -1.0f);
            }
        } else if (wid >= 4) {
            const int tbk = ((wid - 4) >> 1) * 32, vbk = ((wid - 4) & 1) * 32;
            f32x16 acc = mm_tile<4>(zero16(), lds + SC_QK, tbk, lds + SC_S0, vbk, l31, half);
            acc = mm_tile<4, false, true>(acc, lds + SC_MK, tbk, lds + SC_VM, vbk, l31, half);
            store_tile_nm(lds + SC_RHS, vbk, tbk, acc, l31, half, 1.0f);
        }
        __syncthreads();
        if (wid < 4) {
            const int tbk = (wid >> 1) * 32, vbk = (wid & 1) * 32;
            f32x16 acc = mm_tile<4>(zero16(), lds + SC_TT, tbk, lds + SC_RHS, vbk, l31, half);
            store_tile_nm(lds + SC_UN, vbk, tbk, acc, l31, half, -1.0f);
        }
        __syncthreads();
        if (wid < 4) {
            const int kbk = (wid >> 1) * 32, vbk = (wid & 1) * 32;
#pragma unroll
            for (int i = 0; i < 16; ++i) st[i] *= WC[kbk + 8 * (i >> 2) + 4 * half + (i & 3)];
            st = mm_tile<4, true, true>(st, lds + SC_KH, kbk, lds + SC_VM, vbk, l31, half);
            st = mm_tile<4, true, false>(st, lds + SC_BH, kbk, lds + SC_UN, vbk, l31, half);
        } else {
            const int vbk = ((wid - 4) >> 1) * 32, tbk = ((wid - 4) & 1) * 32;
            f32x16 acc = mm_tile<4>(zero16(), lds + SC_S0, vbk, lds + SC_RT, tbk, l31, half);
            acc = mm_tile<4, true, false>(acc, lds + SC_VM, vbk, lds + SC_AK, tbk, l31, half);
            acc = mm_tile<4>(acc, lds + SC_UN, vbk, lds + SC_AB, tbk, l31, half);
            LAS float* yp = (LAS float*)(lds + SC_YF) + (tbk + l31) * 68 + vbk + half * 4;
#pragma unroll
            for (int g = 0; g < 4; ++g) *(LAS f32x4*)(yp + g * 8) = (f32x4){acc[4 * g], acc[4 * g + 1], acc[4 * g + 2], acc[4 * g + 3]};
        }
        __syncthreads();
        if (wid < 4) { const int kbk = (wid >> 1) * 32, vbk = (wid & 1) * 32; store_tile_nm(lds + SC_S0, vbk, kbk, st, l31, half, 1.0f); }
        {
            const LAS float* yp = (const LAS float*)(lds + SC_YF) + tl * 68 + k0;
            const f32x4 y0 = *(const LAS f32x4*)yp, y1 = *(const LAS f32x4*)(yp + 4);
            float y[8] = {y0[0], y0[1], y0[2], y0[3], y1[0], y1[1], y1[2], y1[3]};
            float s = y[0] + y[1] + y[2] + y[3] + y[4] + y[5] + y[6] + y[7];
            s += shx(s, lane, 1); s += shx(s, lane, 2); s += shx(s, lane, 4);
            const float mu = s * (1.0f / 64.0f);
            float q = 0.f;
#pragma unroll
            for (int e = 0; e < 8; ++e) { y[e] -= mu; q += y[e] * y[e]; }
            q += shx(q, lane, 1); q += shx(q, lane, 2); q += shx(q, lane, 4);
            const float rs = rsqrtf(q * (1.0f / 64.0f) + 64e-5f);
            float gng[8], gnb[8];
            { const f32x4 a0 = *(const f32x4*)(p.in[I_GNG] + hc), a1 = *(const f32x4*)(p.in[I_GNG] + hc + 4), b0 = *(const f32x4*)(p.in[I_GNB] + hc), b1 = *(const f32x4*)(p.in[I_GNB] + hc + 4);
#pragma unroll
              for (int e = 0; e < 4; ++e) { gng[e] = a0[e]; gng[4 + e] = a1[e]; gnb[e] = b0[e]; gnb[4 + e] = b1[e]; } }
            float o[8];
#pragma unroll
            for (int e = 0; e < 8; ++e) o[e] = (y[e] * rs * gng[e] + gnb[e] + bonus * v_[e]) * g_[e];
            u32x4 w; w.x = cvt_pk_bf16(o[0], o[1]); w.y = cvt_pk_bf16(o[2], o[3]); w.z = cvt_pk_bf16(o[4], o[5]); w.w = cvt_pk_bf16(o[6], o[7]);
            *(u32x4*)(YR + (tok0 + (size_t)c * 64 + tl) * 512 + hc) = w;
        }
    }
    __syncthreads();
}

#define XB_TMO      128
#define XB_XCNT(j)  (256  + 64 * (j))
#define XB_XSUB(j)  (1280 + 64 * (j))
#define XB_XGEN(j)  (2304 + 64 * (j))
#define XB_TOP      3328
#define XB_TOPGEN   3392
#define XCD_BAR_WORDS 3456
#define XB_SPIN_CAP (1u << 18)

__device__ __forceinline__ unsigned xb_ld(unsigned* p)              { return __hip_atomic_load(p, __ATOMIC_RELAXED, __HIP_MEMORY_SCOPE_AGENT); }
__device__ __forceinline__ unsigned xb_add(unsigned* p, unsigned v) { return __hip_atomic_fetch_add(p, v, __ATOMIC_RELAXED, __HIP_MEMORY_SCOPE_AGENT); }
__device__ __forceinline__ unsigned xb_xcc_id() { return (unsigned)__builtin_amdgcn_s_getreg((3 << 11) | 20) & 0xFu; }
#define XB_SPIN(cond, bar) do { unsigned _sp = 0; while (cond) { __builtin_amdgcn_s_sleep(1); \
    if ((++_sp & 255u) == 0u) { if (xb_ld(&(bar)[XB_TMO])) break; if (_sp > XB_SPIN_CAP) { atomicAdd(&(bar)[XB_TMO], 1u); break; } } } } while (0)

struct XcdBarrier {
    unsigned* bar; unsigned x;
    volatile LAS unsigned* st;
};

__device__ __forceinline__ XcdBarrier xcd_barrier_post(unsigned* bar, volatile LAS unsigned* st) {
    XcdBarrier b; b.bar = bar; b.x = xb_xcc_id(); b.st = st;
    if (threadIdx.x == 0) (void)xb_add(&bar[XB_XCNT(b.x)], 1u);
    return b;
}
__device__ __forceinline__ void xcd_barrier_complete(unsigned* bar, unsigned x, unsigned& nloc, unsigned& nx) {
    const unsigned G = gridDim.x * gridDim.y * gridDim.z;
    unsigned sum, cnt, mine, sp = 0u;
    for (;;) {
        sum = 0u; cnt = 0u; mine = 0u;
#pragma unroll
        for (unsigned j = 0; j < 16; ++j) { const unsigned c = xb_ld(&bar[XB_XCNT(j)]); sum += c; cnt += (c > 0u) ? 1u : 0u; mine = (j == x) ? c : mine; }
        if (sum == G) break;
        __builtin_amdgcn_s_sleep(1);
        if ((++sp & 255u) == 0u) { if (xb_ld(&bar[XB_TMO])) break; if (sp > XB_SPIN_CAP) { atomicAdd(&bar[XB_TMO], 1u); break; } }
    }
    nloc = mine > 0u ? mine : 1u; nx = cnt > 0u ? cnt : 1u;
}

__device__ __forceinline__ void xcd_barrier(const XcdBarrier& b) {
    asm volatile("s_waitcnt vmcnt(0)" ::: "memory");
    __syncthreads();
    if (threadIdx.x == 0) {
        unsigned* bar = b.bar;
        __builtin_amdgcn_s_waitcnt(0);
        unsigned nloc = b.st[0], nx = b.st[1];
        if (nloc == 0u) { xcd_barrier_complete(bar, b.x, nloc, nx); b.st[0] = nloc; b.st[1] = nx; }
        const unsigned old = xb_add(&bar[XB_XSUB(b.x)], 1u);
        const unsigned gen = old / nloc;
        if (old + 1u == (gen + 1u) * nloc) {
            __builtin_amdgcn_fence(__ATOMIC_RELEASE, "agent");
            asm volatile("s_waitcnt vmcnt(0)" ::: "memory");
            const unsigned og = xb_add(&bar[XB_TOP], 1u);
            const unsigned tg = og / nx;
            if (og + 1u == (tg + 1u) * nx) xb_add(&bar[XB_TOPGEN], 1u);
            else XB_SPIN(xb_ld(&bar[XB_TOPGEN]) == tg, bar);
            __builtin_amdgcn_fence(__ATOMIC_ACQUIRE, "agent");
            xb_add(&bar[XB_XGEN(b.x)], 1u);
            asm volatile("s_waitcnt vmcnt(0)" ::: "memory");
        } else {
            XB_SPIN(xb_ld(&bar[XB_XGEN(b.x)]) == gen, bar);
            __builtin_amdgcn_fence(__ATOMIC_ACQUIRE, "agent");
            asm volatile("s_waitcnt vmcnt(0)" ::: "memory");
        }
    }
    __syncthreads();
}

typedef const __attribute__((address_space(4))) Params* kparams_t;
__device__ __forceinline__ Params load_params(kparams_t q) { Params r;
#pragma unroll
    for (int i = 0; i < 32; ++i) r.in[i] = q->in[i];
    r.out = q->out; r.ws = q->ws; return r; }
__global__ void __launch_bounds__(512, 2) mk_fwd(Params p_unused) {
    extern __shared__ __attribute__((aligned(16))) unsigned char shm[];
    LAS unsigned char* lds = (LAS unsigned char*)shm;
    int wsg = __builtin_amdgcn_readfirstlane((int)threadIdx.x >> 6); asm volatile("" : "+s"(wsg));
    kparams_t pp = (kparams_t)__builtin_amdgcn_kernarg_segment_ptr();
#define PQ_ ({ asm volatile("" : "+s"(pp)); pp; })
#define P_ (*PQ_)
    unsigned char* ws = P_.ws;
    volatile LAS unsigned* xst = (volatile LAS unsigned*)(lds + LDS_MAIN);
    if (threadIdx.x < 2) xst[threadIdx.x] = 0u;
    __syncthreads();
    (void)xcd_barrier_post((unsigned*)(ws + OFF_BAR), xst);
#define GSYNC() do { XcdBarrier xb_; xb_.bar = (unsigned*)(P_.ws + OFF_BAR); xb_.x = xb_xcc_id(); xb_.st = xst; xcd_barrier(xb_); } while (0)
    bf16_t* actb = (bf16_t*)(ws + OFF_R1);
    bf16_t* hid = (bf16_t*)(ws + OFF_R2);
    bf16_t* zb = (bf16_t*)P_.out;
    bf16_t* z3 = (bf16_t*)(ws + OFF_R3);

    { const Params pl = load_params(PQ_); prologue_phase(wsg, lds, pl); }
    cg::this_grid().sync();
    asm volatile("" : "+s"(wsg) :: "memory");
    { EpiSwiGLU e{hid}; pg8::gemm_phase<NFF1, DM, DM>(wsg, lds, actb, (const bf16_t*)(ws + OFF_W13_1), e); }
    GSYNC();
    asm volatile("" : "+s"(wsg) :: "memory");
    { EpiZ1 e{P_.in[I_X], zb, 0.5f}; pg8::gemm_phase<DM, DFFP, DFFP>(wsg, lds, hid, (const bf16_t*)(ws + OFF_W2_1), e); }
    GSYNC();
    lnz_phase(wsg, zb, P_.in[I_LN1G], P_.in[I_LN1B], (bf16_t*)P_.out + (size_t)T_TOK * DM, nullptr, (float*)(ws + OFF_STAT1));
    GSYNC();
    bf16_t* proj = (bf16_t*)(ws + OFF_R3);
    bf16_t* lin = (bf16_t*)(ws + OFF_R1); bf16_t* qn = (bf16_t*)(ws + OFF_R1 + 48 * MiB); bf16_t* kvn = (bf16_t*)(ws + OFF_R1 + 96 * MiB);
    bf16_t* yr = (bf16_t*)(ws + OFF_R1); bf16_t* ym = (bf16_t*)(ws + OFF_R1 + 64 * MiB);
    bf16_t* qbuf = (bf16_t*)(ws + OFF_R2 + 192 * MiB);
    bf16_t* kn = (bf16_t*)(ws + OFF_R4); bf16_t* vt = (bf16_t*)(ws + OFF_R4 + 64 * MiB); bf16_t* kpe = (bf16_t*)(ws + OFF_R4 + 128 * MiB);
    bf16_t* h1b = (bf16_t*)P_.out + (size_t)T_TOK * DM;
    bf16_t* ubuf = (bf16_t*)(ws + OFF_R2 + 128 * MiB); bf16_t* gates = (bf16_t*)(ws + OFF_R3);
    unsigned* ctl = (unsigned*)(ws + OFF_CTL);
    asm volatile("" : "+s"(wsg) :: "memory");
    { EpiBf16Store<0> e{proj, PROJ_LD}; pg8::gemm_phase<PROJ_LD, DM, DM>(wsg, lds, (const bf16_t*)P_.out + (size_t)T_TOK * DM, (const bf16_t*)(ws + OFF_WIN), e); }
    GSYNC();
    { const Params pl = load_params(PQ_); prep_phase(wsg, pl); }
    GSYNC();
    asm volatile("" : "+s"(wsg) :: "memory");
    { EpiBf16Store<2> e{qbuf, 768}; pg8::gemm_phase<768, 384, 384>(wsg, lds, qn, (const bf16_t*)(ws + OFF_WQ), e); }
    asm volatile("" : "+s"(wsg) :: "memory");
    { EpiKV e{kn, vt}; pg8::gemm_phase<1024, 256, 256>(wsg, lds, kvn, (const bf16_t*)(ws + OFF_WKV), e); }
    asm volatile("" : "+s"(wsg) :: "memory");
    { EpiLoraAll e{(unsigned short*)(ws + OFF_R2), P_.in[I_W0], P_.in[I_A0]}; pg8::gemm_phase<1536, 384, 384>(wsg, lds, lin, (const bf16_t*)(ws + OFF_WLORA), e); }
    GSYNC();
    if (blockIdx.x < 64) { const Params pl = load_params(PQ_); scan_chain(wsg, lds, pl, (int)blockIdx.x); }
    attn_phase(wsg, lds, qbuf, kn, kpe, vt, ym, ctl, (const float*)(ws + OFF_ROPE));
    GSYNC();
    asm volatile("" : "+s"(wsg) :: "memory");
    { EpiBf16Store<1> e{gates, NGATE}; pg8::gemm_phase<NGATE, DM, DM>(wsg, lds, h1b, (const bf16_t*)(ws + OFF_WIN) + (size_t)PROJ_LD * DM, e); }
    GSYNC();
    asm volatile("" : "+s"(wsg) :: "memory");
    { EpiUp<0> e{ubuf, gates, 0}; pg8::gemm_phase<DM, 512, 512>(wsg, lds, yr, (const bf16_t*)(ws + OFF_WUR), e); }
    asm volatile("" : "+s"(wsg) :: "memory");
    { EpiUp<1> e{ubuf, gates, 1024}; pg8::gemm_phase<DM, 512, 512>(wsg, lds, ym, (const bf16_t*)(ws + OFF_WUM), e); }
    GSYNC();
    asm volatile("" : "+s"(wsg) :: "memory");
    { EpiZLN e{zb, zb, 1.0f, (const float*)(ws + OFF_STAT1), P_.in[I_LN1G], P_.in[I_LN1B]}; pg8::gemm_phase<DM, DM, DM>(wsg, lds, ubuf, (const bf16_t*)(ws + OFF_WO), e); }
    GSYNC();
    lnz_phase(wsg, zb, P_.in[I_LN2G], P_.in[I_LN2B], actb, nullptr, (float*)(ws + OFF_STAT2));
    GSYNC();
    asm volatile("" : "+s"(wsg) :: "memory");
    { EpiSwiGLU e{hid}; pg8::gemm_phase<NFF1, DM, DM>(wsg, lds, actb, (const bf16_t*)(ws + OFF_W13_2), e); }
    GSYNC();
    asm volatile("" : "+s"(wsg) :: "memory");
    { EpiZLN e{zb, z3, 0.5f, (const float*)(ws + OFF_STAT2), P_.in[I_LN2G], P_.in[I_LN2B]}; pg8::gemm_phase<DM, DFFP, DFFP>(wsg, lds, hid, (const bf16_t*)(ws + OFF_W2_2), e); }
    GSYNC();
    lnz_phase(wsg, z3, P_.in[I_LN3G], P_.in[I_LN3B], nullptr, P_.out, nullptr);
}

extern "C" void kernel_launch(void* const* d_in, const int* in_sizes, int n_in, void* d_out, int out_size, void* d_ws, size_t ws_size, hipStream_t stream) {
    static int grid = 0;
    if (grid == 0) {
        int dev = 0, cus = 0, per_cu = 0;
        hipGetDevice(&dev);
        hipDeviceGetAttribute(&cus, hipDeviceAttributeMultiprocessorCount, dev);
        if (hipFuncSetAttribute((const void*)mk_fwd, hipFuncAttributeMaxDynamicSharedMemorySize, LDS_BYTES) != hipSuccess) fprintf(stderr, "hipFuncSetAttribute failed\n");
        hipOccupancyMaxActiveBlocksPerMultiprocessor(&per_cu, (const void*)mk_fwd, 512, LDS_BYTES);
        if (per_cu < 1) { fprintf(stderr, "occupancy query says %d blocks/CU\n", per_cu); per_cu = 1; }
        grid = cus;
        if (ws_size < 1024 * MiB) fprintf(stderr, "workspace too small: %zu\n", ws_size);
    }
    Params p{};
    for (int i = 0; i < 32; ++i) p.in[i] = (const float*)d_in[i];
    p.out = (float*)d_out; p.ws = (unsigned char*)d_ws;
    hipMemsetAsync((unsigned char*)d_ws + OFF_CTL, 0, CTL_BYTES, stream);
    void* args[] = {&p};
    hipError_t e = hipLaunchCooperativeKernel((const void*)mk_fwd, dim3(grid), dim3(512), args, LDS_BYTES, stream);
    if (e != hipSuccess) fprintf(stderr, "cooperative launch failed: %s (grid %d)\n", hipGetErrorString(e), grid);
}
```

```cpp
#include <hip/hip_runtime.h>
#include <hip/hip_cooperative_groups.h>
#include <cstdio>
#include <cstdint>
namespace cg = cooperative_groups;

#define LAS __attribute__((address_space(3)))
typedef unsigned short bf16_t;
typedef short bf16x8 __attribute__((ext_vector_type(8)));
typedef float f32x4 __attribute__((ext_vector_type(4)));
typedef float f32x16 __attribute__((ext_vector_type(16)));
typedef unsigned u32x4 __attribute__((ext_vector_type(4)));
typedef unsigned u32x2 __attribute__((ext_vector_type(2)));

constexpr int T_TOK = 65536, SEQ = 8192, DM = 1024, DFF = 2752, DFFP = 2816, NFF1 = 5632;
constexpr int IN_COLS = 4544, PROJ_LD = 2560, NGATE = 2048;
constexpr float ALPHA = 1.189207115002721f;
constexpr int LDS_MAIN = 131072;
constexpr int LDS_BYTES = LDS_MAIN + 64;

constexpr size_t MiB = 1ull << 20;
constexpr size_t OFF_W13_1 = 0;
constexpr size_t OFF_W2_1  = OFF_W13_1 + (size_t)NFF1 * DM * 2;
constexpr size_t OFF_W13_2 = OFF_W2_1 + (size_t)DM * DFFP * 2;
constexpr size_t OFF_W2_2  = OFF_W13_2 + (size_t)NFF1 * DM * 2;
constexpr size_t OFF_WIN   = OFF_W2_2 + (size_t)DM * DFFP * 2;
constexpr size_t OFF_WLORA = OFF_WIN + (size_t)4608 * DM * 2;
constexpr size_t OFF_WQ    = OFF_WLORA + (size_t)1536 * 384 * 2;
constexpr size_t OFF_WKV   = OFF_WQ + (size_t)768 * 384 * 2;
constexpr size_t OFF_WUR   = OFF_WKV + (size_t)1024 * 256 * 2;
constexpr size_t OFF_WUM   = OFF_WUR + (size_t)1024 * 512 * 2;
constexpr size_t OFF_WO    = OFF_WUM + (size_t)1024 * 512 * 2;
constexpr size_t OFF_ROPE  = OFF_WO + (size_t)1024 * 1024 * 2;
constexpr size_t OFF_CTL   = OFF_ROPE + (size_t)2 * 8192 * 16 * 4;
constexpr size_t OFF_BAR   = OFF_CTL + 4096;
constexpr size_t CTL_BYTES = 4096 + 3456 * 4;
constexpr size_t OFF_STAT1 = OFF_CTL + 32768;
constexpr size_t OFF_STAT2 = OFF_STAT1 + (size_t)65536 * 8;
constexpr size_t OFF_R1    = 56 * MiB;
constexpr size_t OFF_R2    = 184 * MiB;
constexpr size_t OFF_R3    = 536 * MiB;
constexpr size_t OFF_R4    = 856 * MiB;
static_assert(OFF_STAT2 + (size_t)65536 * 8 <= OFF_R1 && CTL_BYTES <= 32768, "weights overflow");

struct Params { const float* in[32]; float* out; unsigned char* ws; };

enum { I_X = 0, I_F1W1, I_F1W3, I_F1W2, I_LN1G, I_LN1B, I_WIN, I_MU, I_W0, I_WDU, I_A0, I_WIU, I_WGU, I_KK, I_KA, I_RK, I_GNG, I_GNB,
       I_QNG, I_WQU, I_KVNG, I_WKVU, I_WUR, I_WUM, I_WO, I_LN2G, I_LN2B, I_F2W1, I_F2W3, I_F2W2, I_LN3G, I_LN3B };

typedef __bf16 bf16v2_t __attribute__((ext_vector_type(2)));
typedef float f32v2_t __attribute__((ext_vector_type(2)));
__device__ __forceinline__ unsigned cvt_pk_bf16(float lo, float hi) { f32v2_t v = {lo, hi}; bf16v2_t b = __builtin_convertvector(v, bf16v2_t); return __builtin_bit_cast(unsigned, b); }
__device__ __forceinline__ float bflo(unsigned w) { return __uint_as_float(w << 16); }
__device__ __forceinline__ float bfhi(unsigned w) { return __uint_as_float(w & 0xffff0000u); }
__device__ __forceinline__ int otid(int wsg) { int l; asm volatile("v_mbcnt_lo_u32_b32 %0, -1, 0\n\tv_mbcnt_hi_u32_b32 %0, -1, %0" : "=v"(l)); return wsg * 64 + l; }
__device__ __forceinline__ float shx(float v, int lane, int m) { return __int_as_float(__builtin_amdgcn_ds_bpermute((lane ^ m) << 2, __float_as_int(v))); }
__device__ __forceinline__ float bf2f(bf16_t b) { return __uint_as_float(((unsigned)b) << 16); }

namespace pg8 {
constexpr int BM = 256, BK = 64, HALF = 128, HTB = HALF * BK * 2, STAGE_BYTES = 8 * HTB, NXCD = 8, WGM = 8;
__host__ __device__ __forceinline__ int lds_byte(int r, int c) { const int st = (r >> 4) * 2 + (c >> 5), rr = r & 15, cc = c & 31, ob = rr * 64 + cc * 2; return st * 1024 + (ob ^ (((ob >> 9) & 1) << 5)); }
__host__ __device__ __forceinline__ void stage_rc(int b, int& R, int& C) { const int st = b / 1024, sb = b % 1024, swz = sb ^ (((sb >> 9) & 1) << 5); R = (st >> 1) * 16 + swz / 64; C = (st & 1) * 32 + (swz % 64) / 2; }
__host__ __device__ __forceinline__ int perm32(int rho) { const int n = rho >> 4, i = rho & 15; return 8 * (i >> 2) + 4 * n + (i & 3); }
struct Unit { int pm, pn; };
struct Gemm { const bf16_t* A; int lda; const bf16_t* Bt; int M, N, K; };
struct StaticOrder {
    int nM, nN, nwg, G, c;
    __device__ void init(int M, int N, int G_, int c_) { nM = M / BM; nN = N / BM; nwg = nM * nN; G = G_; c = c_; }
    __device__ bool next(int i, Unit& u) const {
        const long L = (long)i * G + c; if (L >= nwg) return false;
        int wgid = (int)L; { const int q = nwg / NXCD, r = nwg % NXCD, xcd = wgid % NXCD, off = wgid / NXCD; wgid = (xcd < r ? xcd * (q + 1) : r * (q + 1) + (xcd - r) * q) + off; }
        const int nig = WGM * nN, gid = wgid / nig, fm = gid * WGM, gsz = (nM - fm) < WGM ? (nM - fm) : WGM;
        u.pm = fm + ((wgid % nig) % gsz); u.pn = (wgid % nig) / gsz; return true;
    }
};

template <int N_, int K_, int LDA_, class Epi>
__device__ __forceinline__ void gemm_phase(int wsg, LAS unsigned char* lds, const bf16_t* gA, const bf16_t* gBt, const Epi& E) {
    struct { const bf16_t* A; const bf16_t* Bt; } g{gA, gBt};
    StaticOrder S; S.init(T_TOK, N_, (int)gridDim.x, (int)blockIdx.x);
    const int tid_ = otid(wsg);
    const int tid = tid_, wid = __builtin_amdgcn_readfirstlane(tid >> 6), lane = tid & 63, wr = wid >> 2, wc = wid & 3, fr = lane & 15, fq = lane >> 4;
    constexpr int K = K_, nt = K / BK, lda = LDA_;
    unsigned voffA[2], voffB[2];
#pragma unroll
    for (int i = 0; i < 2; ++i) { int R, C; stage_rc(tid * 16 + i * 8192, R, C); const int Rb = Epi::PERM ? ((R & ~31) + perm32(R & 31)) : R;
        voffA[i] = (unsigned)(R * lda + C) * 2u; voffB[i] = (unsigned)(Rb * K + C) * 2u; }
    constexpr size_t kstep = (size_t)(BK * 2);
    constexpr size_t hstepA = (size_t)HALF * lda * 2, hstepB = (size_t)HALF * K * 2;
    constexpr size_t tstepA = 2 * hstepA, tstepB = 2 * hstepB;
    const unsigned ldsw = (unsigned)wid * 1024u;
    const int aoff = lds_byte(wr * 64 + fr, fq * 8), boff = lds_byte(wc * 32 + fr, fq * 8);
#define PG8_SA(b, h) (((b) * 2 + (h)) * HTB)
#define PG8_SB(b, h) ((4 + (b) * 2 + (h)) * HTB)
#define PG8_STAGE(bufoff, gbase, voff) do { _Pragma("unroll") for (int _i = 0; _i < 2; ++_i) \
        __builtin_amdgcn_global_load_lds((const unsigned*)((const char*)(gbase) + (voff)[_i]), (LAS unsigned*)(lds + (bufoff) + ldsw + _i * 8192), 16, 0, 0); } while (0)
#define PG8_LDA(dst, b, h) do { _Pragma("unroll") for (int m = 0; m < 4; ++m) _Pragma("unroll") for (int k = 0; k < 2; ++k) dst[m][k] = *(const LAS bf16x8*)(lds + PG8_SA(b, h) + aoff + m * 2048 + k * 1024); } while (0)
#define PG8_LDB(dst, b, h) do { _Pragma("unroll") for (int n = 0; n < 2; ++n) _Pragma("unroll") for (int k = 0; k < 2; ++k) dst[n][k] = *(const LAS bf16x8*)(lds + PG8_SB(b, h) + boff + n * 2048 + k * 1024); } while (0)
#define PG8_MMA(ai, bj, At, Bt) do { __builtin_amdgcn_s_setprio(1); _Pragma("unroll") for (int m = 0; m < 4; ++m) _Pragma("unroll") for (int n = 0; n < 2; ++n) _Pragma("unroll") for (int k = 0; k < 2; ++k) \
        acc[ai][bj][m][n] = __builtin_amdgcn_mfma_f32_16x16x32_bf16(Bt[n][k], At[m][k], acc[ai][bj][m][n], 0, 0, 0); __builtin_amdgcn_s_setprio(0); } while (0)
#define PG8_WAIT_V(n) asm volatile("s_waitcnt vmcnt(" #n ")" ::: "memory")
#define PG8_WAIT_L(n) asm volatile("s_waitcnt lgkmcnt(" #n ")" ::: "memory")
#define PG8_BAR __builtin_amdgcn_s_barrier()
#define PG8_SCHED __builtin_amdgcn_sched_barrier(0)
    Unit cur, nxt; int ui = 0;
    if (!S.next(0, cur)) return;
    f32x4 acc[2][2][4][2];
#pragma unroll
    for (int a = 0; a < 2; ++a)
#pragma unroll
        for (int b = 0; b < 2; ++b)
#pragma unroll
            for (int m = 0; m < 4; ++m)
#pragma unroll
                for (int n = 0; n < 2; ++n) acc[a][b][m][n] = (f32x4){0.f, 0.f, 0.f, 0.f};
    bf16x8 At[4][2], B0[2][2], B1[2][2];
    const char* cA = (const char*)g.A + (size_t)cur.pm * tstepA; const char* cB = (const char*)g.Bt + (size_t)cur.pn * tstepB;
    PG8_STAGE(PG8_SB(0, 0), cB, voffB); PG8_STAGE(PG8_SB(0, 1), cB + hstepB, voffB); PG8_STAGE(PG8_SA(0, 0), cA, voffA); PG8_STAGE(PG8_SA(0, 1), cA + hstepA, voffA);
    if (wr == 1) PG8_BAR;
    PG8_WAIT_V(2); PG8_BAR;
    PG8_STAGE(PG8_SB(1, 0), cB + kstep, voffB); PG8_STAGE(PG8_SA(1, 0), cA + kstep, voffA); PG8_STAGE(PG8_SB(1, 1), cB + hstepB + kstep, voffB);
    PG8_WAIT_V(6); PG8_BAR;
    for (;;) {
        const bool has_next = S.next(ui + 1, nxt);
        const char* nA = has_next ? (const char*)g.A + (size_t)nxt.pm * tstepA : cA; const char* nB = has_next ? (const char*)g.Bt + (size_t)nxt.pn * tstepB : cB;
#pragma unroll 1
        for (int t = 0; t < nt; t += 2) {
            const bool last = (t == nt - 2);
            const char* a1 = cA + (size_t)(t + 1) * kstep;
            const char* a2 = last ? nA : cA + (size_t)(t + 2) * kstep; const char* b2 = last ? nB : cB + (size_t)(t + 2) * kstep;
            const char* a3 = a2 + kstep; const char* b3 = b2 + kstep;
            PG8_LDB(B0, 0, 0); PG8_LDB(B1, 0, 1); PG8_SCHED; PG8_LDA(At, 0, 0); PG8_STAGE(PG8_SA(1, 1), a1 + hstepA, voffA);
            PG8_WAIT_V(8); PG8_WAIT_L(0); PG8_BAR; PG8_MMA(0, 0, At, B0); PG8_MMA(0, 1, At, B1); PG8_BAR; PG8_SCHED;
            PG8_LDA(At, 0, 1); PG8_STAGE(PG8_SB(0, 0), b2, voffB); PG8_STAGE(PG8_SB(0, 1), b2 + hstepB, voffB); PG8_STAGE(PG8_SA(0, 0), a2, voffA);
            PG8_WAIT_V(8); PG8_WAIT_L(0); PG8_BAR; PG8_MMA(1, 0, At, B0); PG8_MMA(1, 1, At, B1); PG8_BAR; PG8_SCHED;
            PG8_LDB(B0, 1, 0); PG8_LDB(B1, 1, 1); PG8_SCHED; PG8_LDA(At, 1, 0); PG8_STAGE(PG8_SA(0, 1), a2 + hstepA, voffA);
            PG8_WAIT_V(8); PG8_WAIT_L(0); PG8_BAR; PG8_MMA(0, 0, At, B0); PG8_MMA(0, 1, At, B1); PG8_BAR; PG8_SCHED;
            PG8_LDA(At, 1, 1); PG8_STAGE(PG8_SB(1, 0), b3, voffB); PG8_STAGE(PG8_SB(1, 1), b3 + hstepB, voffB); PG8_STAGE(PG8_SA(1, 0), a3, voffA);
            PG8_WAIT_V(8); PG8_WAIT_L(0); PG8_BAR; PG8_MMA(1, 0, At, B0); PG8_MMA(1, 1, At, B1); PG8_BAR; PG8_SCHED;
        }
        if (wr == 0) PG8_BAR;
        E(acc, cur, wr, wc, fr, fq);
        if (!has_next) break;
#pragma unroll
        for (int a = 0; a < 2; ++a)
#pragma unroll
            for (int b = 0; b < 2; ++b)
#pragma unroll
                for (int m = 0; m < 4; ++m)
#pragma unroll
                    for (int n = 0; n < 2; ++n) acc[a][b][m][n] = (f32x4){0.f, 0.f, 0.f, 0.f};
        cur = nxt; cA = nA; cB = nB; ++ui;
        if (wr == 1) PG8_BAR;
    }
    PG8_WAIT_V(0);
    PG8_BAR;
#undef PG8_SA
#undef PG8_SB
#undef PG8_STAGE
#undef PG8_LDA
#undef PG8_LDB
#undef PG8_MMA
#undef PG8_WAIT_V
#undef PG8_WAIT_L
#undef PG8_BAR
#undef PG8_SCHED
}
}
using pg8::Unit;


struct EpiSwiGLU {
    static constexpr bool PERM = true;
    bf16_t* O;
    __device__ __forceinline__ void operator()(const f32x4 (&acc)[2][2][4][2], const Unit& u, int wr, int wc, int fr, int fq) const {
        const int row0 = u.pm * 256 + wr * 64 + fr, col0 = u.pn * 128 + wc * 32 + 8 * fq;
#pragma unroll
        for (int ai = 0; ai < 2; ++ai)
#pragma unroll
            for (int m = 0; m < 4; ++m) {
                float h[8];
#pragma unroll
                for (int n = 0; n < 2; ++n)
#pragma unroll
                    for (int j = 0; j < 4; ++j) { const float gt = acc[ai][0][m][n][j], up = acc[ai][1][m][n][j]; h[n * 4 + j] = gt * up * __builtin_amdgcn_rcpf(1.0f + __builtin_amdgcn_exp2f(-gt)); }
                u32x4 w; w.x = cvt_pk_bf16(h[0], h[1]); w.y = cvt_pk_bf16(h[2], h[3]); w.z = cvt_pk_bf16(h[4], h[5]); w.w = cvt_pk_bf16(h[6], h[7]);
                __builtin_nontemporal_store(w, (u32x4*)(O + (size_t)(row0 + ai * 128 + m * 16) * DFFP + col0));
            }
    }
};
struct EpiResid {
    static constexpr bool PERM = false;
    const float* res; float* out; float sc;
    __device__ __forceinline__ void operator()(const f32x4 (&acc)[2][2][4][2], const Unit& u, int wr, int wc, int fr, int fq) const {
        const int row0 = u.pm * 256 + wr * 64 + fr, col0 = u.pn * 256 + wc * 32 + 4 * fq;
#pragma unroll
        for (int ai = 0; ai < 2; ++ai)
#pragma unroll
            for (int m = 0; m < 4; ++m) {
                const size_t ro = (size_t)(row0 + ai * 128 + m * 16) * DM + col0;
                f32x4 rv[2][2];
#pragma unroll
                for (int bj = 0; bj < 2; ++bj)
#pragma unroll
                    for (int n = 0; n < 2; ++n) rv[bj][n] = *(const f32x4*)(res + ro + bj * 128 + n * 16);
#pragma unroll
                for (int bj = 0; bj < 2; ++bj)
#pragma unroll
                    for (int n = 0; n < 2; ++n) *(f32x4*)(out + ro + bj * 128 + n * 16) = rv[bj][n] * ALPHA + acc[ai][bj][m][n] * sc;
            }
    }
};


constexpr float QSCALE = 0.10206207261596575f * 1.4426950408889634f;
template <int MODE  > struct EpiBf16Store {
    static constexpr bool PERM = true;
    bf16_t* O; int ldc;
    __device__ __forceinline__ void operator()(const f32x4 (&acc)[2][2][4][2], const Unit& u, int wr, int wc, int fr, int fq) const {
        const int row0 = u.pm * 256 + wr * 64 + fr, col0 = u.pn * 256 + wc * 32 + 8 * fq;
#pragma unroll
        for (int ai = 0; ai < 2; ++ai)
#pragma unroll
            for (int m = 0; m < 4; ++m)
#pragma unroll
                for (int bj = 0; bj < 2; ++bj) {
                    float h[8];
#pragma unroll
                    for (int n = 0; n < 2; ++n)
#pragma unroll
                        for (int j = 0; j < 4; ++j) { const float v = acc[ai][bj][m][n][j]; h[n * 4 + j] = MODE == 1 ? __builtin_amdgcn_rcpf(1.0f + __builtin_amdgcn_exp2f(-v)) : (MODE == 2 ? v * QSCALE : v); }
                    u32x4 w; w.x = cvt_pk_bf16(h[0], h[1]); w.y = cvt_pk_bf16(h[2], h[3]); w.z = cvt_pk_bf16(h[4], h[5]); w.w = cvt_pk_bf16(h[6], h[7]);
                    __builtin_nontemporal_store(w, (u32x4*)(O + (size_t)(row0 + ai * 128 + m * 16) * ldc + col0 + bj * 128));
                }
    }
};
struct EpiKV {
    static constexpr bool PERM = true;
    bf16_t* KN; bf16_t* VT;
    __device__ __forceinline__ void operator()(const f32x4 (&acc)[2][2][4][2], const Unit& u, int wr, int wc, int fr, int fq) const {
        const int row0 = u.pm * 256 + wr * 64 + fr, col0 = u.pn * 256 + wc * 32 + 8 * fq;
#pragma unroll
        for (int ai = 0; ai < 2; ++ai)
#pragma unroll
            for (int m = 0; m < 4; ++m) {
                const int row = row0 + ai * 128 + m * 16, pos = row & (SEQ - 1), b = row >> 13;
#pragma unroll
                for (int bj = 0; bj < 2; ++bj) {
                    const int c0 = col0 + bj * 128, hd = c0 >> 7, within = c0 & 127;
                    float h[8];
#pragma unroll
                    for (int n = 0; n < 2; ++n)
#pragma unroll
                        for (int j = 0; j < 4; ++j) h[n * 4 + j] = acc[ai][bj][m][n][j];
                    u32x4 w; w.x = cvt_pk_bf16(h[0], h[1]); w.y = cvt_pk_bf16(h[2], h[3]); w.z = cvt_pk_bf16(h[4], h[5]); w.w = cvt_pk_bf16(h[6], h[7]);
                    if (within < 64) { *(u32x4*)(KN + (size_t)row * 512 + hd * 64 + within) = w; }
                    else {
                        bf16_t* vp = VT + ((size_t)((b * 8 + hd) * 64 + (within - 64))) * SEQ + pos;
                        vp[0 * SEQ] = (bf16_t)(w.x & 0xffffu); vp[1 * SEQ] = (bf16_t)(w.x >> 16); vp[2 * SEQ] = (bf16_t)(w.y & 0xffffu); vp[3 * SEQ] = (bf16_t)(w.y >> 16);
                        vp[4 * SEQ] = (bf16_t)(w.z & 0xffffu); vp[5 * SEQ] = (bf16_t)(w.z >> 16); vp[6 * SEQ] = (bf16_t)(w.w & 0xffffu); vp[7 * SEQ] = (bf16_t)(w.w >> 16);
                    }
                }
            }
    }
};
template <int MODE> struct EpiUp {
    static constexpr bool PERM = true;
    bf16_t* U; const bf16_t* G; int goff;
    __device__ __forceinline__ void operator()(const f32x4 (&acc)[2][2][4][2], const Unit& u, int wr, int wc, int fr, int fq) const {
        const int row0 = u.pm * 256 + wr * 64 + fr, col0 = u.pn * 256 + wc * 32 + 8 * fq;
#pragma unroll
        for (int ai = 0; ai < 2; ++ai)
#pragma unroll
            for (int m = 0; m < 4; ++m)
#pragma unroll
                for (int bj = 0; bj < 2; ++bj) {
                    const size_t row = (size_t)(row0 + ai * 128 + m * 16); const int c0 = col0 + bj * 128;
                    const u32x4 gw = *(const u32x4*)(G + row * NGATE + goff + c0);
                    float h[8];
#pragma unroll
                    for (int n = 0; n < 2; ++n)
#pragma unroll
                        for (int j = 0; j < 4; ++j) h[n * 4 + j] = acc[ai][bj][m][n][j];
                    h[0] *= bflo(gw.x); h[1] *= bfhi(gw.x); h[2] *= bflo(gw.y); h[3] *= bfhi(gw.y); h[4] *= bflo(gw.z); h[5] *= bfhi(gw.z); h[6] *= bflo(gw.w); h[7] *= bfhi(gw.w);
                    if (MODE == 1) { const u32x4 uw = *(const u32x4*)(U + row * DM + c0);
                        h[0] += bflo(uw.x); h[1] += bfhi(uw.x); h[2] += bflo(uw.y); h[3] += bfhi(uw.y); h[4] += bflo(uw.z); h[5] += bfhi(uw.z); h[6] += bflo(uw.w); h[7] += bfhi(uw.w); }
                    u32x4 w; w.x = cvt_pk_bf16(h[0], h[1]); w.y = cvt_pk_bf16(h[2], h[3]); w.z = cvt_pk_bf16(h[4], h[5]); w.w = cvt_pk_bf16(h[6], h[7]);
                    *(u32x4*)(U + row * DM + c0) = w;
                }
    }
};

typedef _Float16 f16v2_t __attribute__((ext_vector_type(2)));
__device__ __forceinline__ unsigned cvt_pk_f16(float lo, float hi) { f32v2_t v = {lo, hi}; f16v2_t b = __builtin_convertvector(v, f16v2_t); return __builtin_bit_cast(unsigned, b); }
__device__ __forceinline__ float f16lo(unsigned w) { f16v2_t b = __builtin_bit_cast(f16v2_t, w); return (float)b[0]; }
__device__ __forceinline__ float f16hi(unsigned w) { f16v2_t b = __builtin_bit_cast(f16v2_t, w); return (float)b[1]; }
template <int KIND> struct EpiLora {
    static constexpr bool PERM = true;
    unsigned short* O; const float* bias;
    __device__ __forceinline__ void operator()(const f32x4 (&acc)[2][2][4][2], const Unit& u, int wr, int wc, int fr, int fq) const {
        const int row0 = u.pm * 256 + wr * 64 + fr, col0 = u.pn * 256 + wc * 32 + 8 * fq;
#pragma unroll
        for (int ai = 0; ai < 2; ++ai)
#pragma unroll
            for (int m = 0; m < 4; ++m)
#pragma unroll
                for (int bj = 0; bj < 2; ++bj) {
                    const int c0 = col0 + bj * 128;
                    f32x4 b0 = (f32x4){0.f, 0.f, 0.f, 0.f}, b1 = b0;
                    if (KIND != 2) { b0 = *(const f32x4*)(bias + c0); b1 = *(const f32x4*)(bias + c0 + 4); }
                    float h[8];
#pragma unroll
                    for (int n = 0; n < 2; ++n)
#pragma unroll
                        for (int j = 0; j < 4; ++j) {
                            const float x = acc[ai][bj][m][n][j] + (n == 0 ? b0[j] : b1[j]);
                            float o;
                            if (KIND == 0) o = 0.6065306597126334f * __builtin_amdgcn_rcpf(1.0f + __expf(-x));
                            else if (KIND == 1) o = __builtin_amdgcn_rcpf(1.0f + __expf(-x));
                            else o = x;
                            h[n * 4 + j] = o;
                        }
                    u32x4 w; w.x = cvt_pk_f16(h[0], h[1]); w.y = cvt_pk_f16(h[2], h[3]); w.z = cvt_pk_f16(h[4], h[5]); w.w = cvt_pk_f16(h[6], h[7]);
                    *(u32x4*)(O + (size_t)(row0 + ai * 128 + m * 16) * 1536 + c0) = w;
                }
    }
};

struct EpiResidLN {
    static constexpr bool PERM = false;
    const float* z; float* out; float sc; const float* stat; const float* g; const float* b;
    __device__ __forceinline__ void operator()(const f32x4 (&acc)[2][2][4][2], const Unit& u, int wr, int wc, int fr, int fq) const {
        const int row0 = u.pm * 256 + wr * 64 + fr, col0 = u.pn * 256 + wc * 32 + 4 * fq;
#pragma unroll
        for (int ai = 0; ai < 2; ++ai)
#pragma unroll
            for (int m = 0; m < 4; ++m) {
                __builtin_amdgcn_sched_barrier(0);
                const int row = row0 + ai * 128 + m * 16;
                const size_t ro = (size_t)row * DM + col0;
                const float mu = stat[2 * row], rs = stat[2 * row + 1];
#pragma unroll
                for (int bj = 0; bj < 2; ++bj)
#pragma unroll
                    for (int n = 0; n < 2; ++n) {
                        const f32x4 zv = *(const f32x4*)(z + ro + bj * 128 + n * 16);
                        const f32x4 gv = *(const f32x4*)(g + col0 + bj * 128 + n * 16), bv = *(const f32x4*)(b + col0 + bj * 128 + n * 16);
                        const f32x4 h = (zv - mu) * rs * gv + bv;
                        *(f32x4*)(out + ro + bj * 128 + n * 16) = h * ALPHA + acc[ai][bj][m][n] * sc;
                    }
            }
    }
};

struct EpiZ1 {
    static constexpr bool PERM = true;
    const float* x; bf16_t* z; float sc;
    __device__ __forceinline__ void operator()(const f32x4 (&acc)[2][2][4][2], const Unit& u, int wr, int wc, int fr, int fq) const {
        const int row0 = u.pm * 256 + wr * 64 + fr, col0 = u.pn * 256 + wc * 32 + 8 * fq;
#pragma unroll
        for (int ai = 0; ai < 2; ++ai)
#pragma unroll
            for (int m = 0; m < 4; ++m) {
#pragma unroll
                for (int bj = 0; bj < 2; ++bj) {
                    const size_t o = (size_t)(row0 + ai * 128 + m * 16) * DM + col0 + bj * 128;
                    const f32x4 x0 = *(const f32x4*)(x + o), x1 = *(const f32x4*)(x + o + 4);
                    const f32x4 r0 = x0 * ALPHA + acc[ai][bj][m][0] * sc, r1 = x1 * ALPHA + acc[ai][bj][m][1] * sc;
                    u32x4 w; w.x = cvt_pk_bf16(r0[0], r0[1]); w.y = cvt_pk_bf16(r0[2], r0[3]); w.z = cvt_pk_bf16(r1[0], r1[1]); w.w = cvt_pk_bf16(r1[2], r1[3]);
                    __builtin_nontemporal_store(w, (u32x4*)(z + o));
                }
            }
    }
};
struct EpiZLN {
    static constexpr bool PERM = true;
    const bf16_t* zin; bf16_t* zout; float sc; const float* stat; const float* g; const float* b;
    __device__ __forceinline__ void operator()(const f32x4 (&acc)[2][2][4][2], const Unit& u, int wr, int wc, int fr, int fq) const {
        const int row0 = u.pm * 256 + wr * 64 + fr, col0 = u.pn * 256 + wc * 32 + 8 * fq;
#pragma unroll
        for (int ai = 0; ai < 2; ++ai)
#pragma unroll
            for (int m = 0; m < 4; ++m) {
                const int row = row0 + ai * 128 + m * 16;
                const float mu = stat[2 * row], rs = stat[2 * row + 1];
#pragma unroll
                for (int bj = 0; bj < 2; ++bj) {
                    const int c0 = col0 + bj * 128;
                    const size_t o = (size_t)row * DM + c0;
                    const u32x4 zw = *(const u32x4*)(zin + o);
                    const f32x4 g0 = *(const f32x4*)(g + c0), g1 = *(const f32x4*)(g + c0 + 4), b0 = *(const f32x4*)(b + c0), b1 = *(const f32x4*)(b + c0 + 4);
                    const f32x4 z0 = (f32x4){bflo(zw.x), bfhi(zw.x), bflo(zw.y), bfhi(zw.y)}, z1 = (f32x4){bflo(zw.z), bfhi(zw.z), bflo(zw.w), bfhi(zw.w)};
                    const f32x4 h0 = (z0 - mu) * rs * g0 + b0, h1 = (z1 - mu) * rs * g1 + b1;
                    const f32x4 r0 = h0 * ALPHA + acc[ai][bj][m][0] * sc, r1 = h1 * ALPHA + acc[ai][bj][m][1] * sc;
                    u32x4 w; w.x = cvt_pk_bf16(r0[0], r0[1]); w.y = cvt_pk_bf16(r0[2], r0[3]); w.z = cvt_pk_bf16(r1[0], r1[1]); w.w = cvt_pk_bf16(r1[2], r1[3]);
                    __builtin_nontemporal_store(w, (u32x4*)(zout + o));
                }
            }
    }
};

struct EpiLoraAll {
    static constexpr bool PERM = true;
    unsigned short* O; const float* w0; const float* a0;
    __device__ __forceinline__ void operator()(const f32x4 (&acc)[2][2][4][2], const Unit& u, int wr, int wc, int fr, int fq) const {
        const int kind = u.pn >> 1;
        Unit v; v.pm = u.pm; v.pn = u.pn & 1;
        if (kind == 0) { EpiLora<0> e{O, w0}; e(acc, v, wr, wc, fr, fq); }
        else if (kind == 1) { EpiLora<1> e{O + 512, a0}; e(acc, v, wr, wc, fr, fq); }
        else { EpiLora<2> e{O + 1024, nullptr}; e(acc, v, wr, wc, fr, fq); }
    }
};
template <class F>
__device__ __forceinline__ void cvt_job(int wsg, LAS unsigned char* lds, bf16_t* dst, int Np, int Kp, F f) {
    const int tid = otid(wsg);
    const int ntn = Np / 64, ntk = Kp / 64, ntiles = ntn * ntk;
    LAS bf16_t* T = (LAS bf16_t*)lds;
    for (int t = blockIdx.x; t < ntiles; t += gridDim.x) {
        const int n0 = (t % ntn) * 64, k0 = (t / ntn) * 64;
        __syncthreads();
#pragma unroll
        for (int i = 0; i < 8; ++i) {
            const int n = tid & 63, k = (tid >> 6) + 8 * i;
            const float v = f(n0 + n, k0 + k);
            T[n * 66 + k] = (bf16_t)(cvt_pk_bf16(v, 0.f) & 0xffffu);
        }
        __syncthreads();
        {
            const int n = tid >> 3, ks = (tid & 7) * 8;
            const LAS unsigned* rp = (const LAS unsigned*)(T + n * 66 + ks);
            u32x4 w; w.x = rp[0]; w.y = rp[1]; w.z = rp[2]; w.w = rp[3];
            *(u32x4*)(dst + (size_t)(n0 + n) * Kp + k0 + ks) = w;
        }
    }
}

__device__ void prologue_phase(int wsg, LAS unsigned char* lds, const Params& p) {
    unsigned char* ws = p.ws;
#pragma unroll 1
    for (int f = 0; f < 2; ++f) {
        const float* w1 = p.in[f ? I_F2W1 : I_F1W1]; const float* w3 = p.in[f ? I_F2W3 : I_F1W3]; const float* w2 = p.in[f ? I_F2W2 : I_F1W2];
        cvt_job(wsg, lds, (bf16_t*)(ws + (f ? OFF_W13_2 : OFF_W13_1)), NFF1, DM, [=](int n, int k) -> float {
            const int pn = n >> 8, half = (n >> 7) & 1, c = pn * 128 + (n & 127);
            return c < DFF ? (half ? w3[(size_t)k * DFF + c] * 0.6931471805599453f : w1[(size_t)k * DFF + c] * 1.4426950408889634f) : 0.f; });
        cvt_job(wsg, lds, (bf16_t*)(ws + (f ? OFF_W2_2 : OFF_W2_1)), DM, DFFP, [=](int n, int k) -> float { return k < DFF ? w2[(size_t)k * DM + n] : 0.f; });
    }
    {
        const float* w = p.in[I_WIN];
        cvt_job(wsg, lds, (bf16_t*)(ws + OFF_WIN), 4608, DM, [=](int n, int k) -> float {
            const int c = n < 2496 ? n : (n < 2560 ? -1 : n - 64);
            return c < 0 ? 0.f : w[(size_t)k * IN_COLS + c] * (n >= 2560 ? 1.4426950408889634f : 1.0f); });
    }
    {
        const float* wd = p.in[I_WDU]; const float* wi = p.in[I_WIU]; const float* wg = p.in[I_WGU];
        cvt_job(wsg, lds, (bf16_t*)(ws + OFF_WLORA), 1536, 384, [=](int n, int k) -> float {
            if (n < 512) return k < 64 ? wd[k * 512 + n] : 0.f;
            if (n < 1024) return (k >= 64 && k < 128) ? wi[(k - 64) * 512 + (n - 512)] : 0.f;
            return (k >= 128 && k < 288) ? wg[(k - 128) * 512 + (n - 1024)] : 0.f; });
    }
    {
        const float* w = p.in[I_WQU];
        cvt_job(wsg, lds, (bf16_t*)(ws + OFF_WQ), 768, 384, [=](int n, int k) -> float {
            const int hd = n / 96, s = n % 96; int o = s;
            if (s >= 64) { const int pp = s - 64, i = pp >> 1; o = 64 + ((pp & 1) ? i + 16 : i); }
            return w[k * 768 + hd * 96 + o]; });
    }
    { const float* w = p.in[I_WKVU]; cvt_job(wsg, lds, (bf16_t*)(ws + OFF_WKV), 1024, 256, [=](int n, int k) -> float { return w[k * 1024 + n]; }); }
    { const float* w = p.in[I_WUR]; cvt_job(wsg, lds, (bf16_t*)(ws + OFF_WUR), 1024, 512, [=](int n, int k) -> float { return w[k * 1024 + n]; }); }
    { const float* w = p.in[I_WUM]; cvt_job(wsg, lds, (bf16_t*)(ws + OFF_WUM), 1024, 512, [=](int n, int k) -> float { return w[k * 1024 + n]; }); }
    { const float* w = p.in[I_WO]; cvt_job(wsg, lds, (bf16_t*)(ws + OFF_WO), 1024, 1024, [=](int n, int k) -> float { return w[k * 1024 + n]; }); }
    {
        float* rc = (float*)(ws + OFF_ROPE);
        const int gstride = gridDim.x * 512;
        for (int i = blockIdx.x * 512 + otid(wsg); i < 8192 * 16; i += gstride) {
            const int pos = i >> 4, f = i & 15;
            const float inv = powf(10000.0f, -(float)f * (1.0f / 16.0f));
            const float ang = (float)pos * inv;
            rc[i] = cosf(ang); rc[8192 * 16 + i] = sinf(ang);
        }
    }
    {
        const float* x = p.in[I_X]; bf16_t* xb = (bf16_t*)(ws + OFF_R1);
        const long total = (long)T_TOK * DM / 8, gstride = (long)gridDim.x * 512;
        for (long i = (long)blockIdx.x * 512 + otid(wsg); i < total; i += gstride) {
            const f32x4 a = __builtin_nontemporal_load((const f32x4*)(x + i * 8)), b = __builtin_nontemporal_load((const f32x4*)(x + i * 8 + 4));
            u32x4 w; w.x = cvt_pk_bf16(a[0], a[1]); w.y = cvt_pk_bf16(a[2], a[3]); w.z = cvt_pk_bf16(b[0], b[1]); w.w = cvt_pk_bf16(b[2], b[3]);
            *(u32x4*)(xb + i * 8) = w;
        }
    }
}

__device__ void ln_phase(int wsg, float* io, const float* g, const float* b, bf16_t* ob, float pre) {
    const int t_ = otid(wsg); const int lane = t_ & 63, wv = blockIdx.x * 8 + (t_ >> 6), nw = gridDim.x * 8;
    f32x4 gv[4], bv[4];
#pragma unroll
    for (int i = 0; i < 4; ++i) { gv[i] = *(const f32x4*)(g + i * 256 + lane * 4); bv[i] = *(const f32x4*)(b + i * 256 + lane * 4); }
    for (int row = wv; row < T_TOK; row += nw) {
        float* rp = io + (size_t)row * DM + lane * 4;
        f32x4 v[4]; float s = 0.f;
#pragma unroll
        for (int i = 0; i < 4; ++i) { v[i] = *(const f32x4*)(rp + i * 256) * pre; s += v[i][0] + v[i][1] + v[i][2] + v[i][3]; }
#pragma unroll
        for (int o = 32; o > 0; o >>= 1) s += shx(s, lane, o);
        const float mu = s * (1.0f / DM);
        float q = 0.f;
#pragma unroll
        for (int i = 0; i < 4; ++i) { v[i] = v[i] - mu; q += v[i][0] * v[i][0] + v[i][1] * v[i][1] + v[i][2] * v[i][2] + v[i][3] * v[i][3]; }
#pragma unroll
        for (int o = 32; o > 0; o >>= 1) q += shx(q, lane, o);
        const float rs = rsqrtf(q * (1.0f / DM) + 1e-5f);
#pragma unroll
        for (int i = 0; i < 4; ++i) {
            const f32x4 y = v[i] * rs * gv[i] + bv[i];
            *(f32x4*)(rp + i * 256) = y;
            if (ob) { u32x2 w; w.x = cvt_pk_bf16(y[0], y[1]); w.y = cvt_pk_bf16(y[2], y[3]); *(u32x2*)(ob + (size_t)row * DM + i * 256 + lane * 4) = w; }
        }
    }
}

__device__ void ln_stats_phase(int wsg, const float* zin, const float* g, const float* b, bf16_t* ob, float* stat) {
    const int t_ = otid(wsg); const int lane = t_ & 63, wv = blockIdx.x * 8 + (t_ >> 6), nw = gridDim.x * 8;
    f32x4 gv[4], bv[4];
#pragma unroll
    for (int i = 0; i < 4; ++i) { gv[i] = *(const f32x4*)(g + i * 256 + lane * 4); bv[i] = *(const f32x4*)(b + i * 256 + lane * 4); }
    for (int row = wv; row < T_TOK; row += nw) {
        const float* rp = zin + (size_t)row * DM + lane * 4;
        f32x4 v[4]; float s = 0.f;
#pragma unroll
        for (int i = 0; i < 4; ++i) { v[i] = *(const f32x4*)(rp + i * 256); s += v[i][0] + v[i][1] + v[i][2] + v[i][3]; }
#pragma unroll
        for (int o = 32; o > 0; o >>= 1) s += shx(s, lane, o);
        const float mu = s * (1.0f / DM);
        float q = 0.f;
#pragma unroll
        for (int i = 0; i < 4; ++i) { v[i] = v[i] - mu; q += v[i][0] * v[i][0] + v[i][1] * v[i][1] + v[i][2] * v[i][2] + v[i][3] * v[i][3]; }
#pragma unroll
        for (int o = 32; o > 0; o >>= 1) q += shx(q, lane, o);
        const float rs = rsqrtf(q * (1.0f / DM) + 1e-5f);
        if (lane == 0) { stat[2 * row] = mu; stat[2 * row + 1] = rs; }
#pragma unroll
        for (int i = 0; i < 4; ++i) {
            const f32x4 y = v[i] * rs * gv[i] + bv[i];
            u32x2 w; w.x = cvt_pk_bf16(y[0], y[1]); w.y = cvt_pk_bf16(y[2], y[3]); *(u32x2*)(ob + (size_t)row * DM + i * 256 + lane * 4) = w;
        }
    }
}

__device__ void lnz_phase(int wsg, const bf16_t* zin, const float* g, const float* b, bf16_t* ob, float* of, float* stat) {
    const int t_ = otid(wsg); const int lane = t_ & 63, wv = blockIdx.x * 8 + (t_ >> 6), nw = gridDim.x * 8;
    f32x4 gv[4], bv[4];
#pragma unroll
    for (int i = 0; i < 4; ++i) { gv[i] = *(const f32x4*)(g + i * 256 + lane * 4); bv[i] = *(const f32x4*)(b + i * 256 + lane * 4); }
    for (int row = wv; row < T_TOK; row += nw) {
        const bf16_t* rp = zin + (size_t)row * DM + lane * 4;
        f32x4 v[4]; float s = 0.f;
#pragma unroll
        for (int i = 0; i < 4; ++i) { const u32x2 w = *(const u32x2*)(rp + i * 256); v[i] = (f32x4){bflo(w.x), bfhi(w.x), bflo(w.y), bfhi(w.y)}; s += v[i][0] + v[i][1] + v[i][2] + v[i][3]; }
#pragma unroll
        for (int o = 32; o > 0; o >>= 1) s += shx(s, lane, o);
        const float mu = s * (1.0f / DM);
        float q = 0.f;
#pragma unroll
        for (int i = 0; i < 4; ++i) { v[i] = v[i] - mu; q += v[i][0] * v[i][0] + v[i][1] * v[i][1] + v[i][2] * v[i][2] + v[i][3] * v[i][3]; }
#pragma unroll
        for (int o = 32; o > 0; o >>= 1) q += shx(q, lane, o);
        const float rs = rsqrtf(q * (1.0f / DM) + 1e-5f);
        if (stat && lane == 0) { stat[2 * row] = mu; stat[2 * row + 1] = rs; }
#pragma unroll
        for (int i = 0; i < 4; ++i) {
            const f32x4 y = v[i] * rs * gv[i] + bv[i];
            if (of) __builtin_nontemporal_store(y, (f32x4*)(of + (size_t)row * DM + i * 256 + lane * 4));
            if (ob) { u32x2 w; w.x = cvt_pk_bf16(y[0], y[1]); w.y = cvt_pk_bf16(y[2], y[3]); *(u32x2*)(ob + (size_t)row * DM + i * 256 + lane * 4) = w; }
        }
    }
}

__device__ void f32_to_bf16_phase(int wsg, const float* src, bf16_t* dst, long n8) {
    const long gstride = (long)gridDim.x * 512;
    for (long i = (long)blockIdx.x * 512 + otid(wsg); i < n8; i += gstride) {
        const f32x4 a = *(const f32x4*)(src + i * 8), b = *(const f32x4*)(src + i * 8 + 4);
        u32x4 w; w.x = cvt_pk_bf16(a[0], a[1]); w.y = cvt_pk_bf16(a[2], a[3]); w.z = cvt_pk_bf16(b[0], b[1]); w.w = cvt_pk_bf16(b[2], b[3]);
        *(u32x4*)(dst + i * 8) = w;
    }
}

__device__ __forceinline__ float wave_sum(float s, int lane) {
#pragma unroll
    for (int o = 32; o > 0; o >>= 1) s += shx(s, lane, o);
    return s;
}
__device__ __forceinline__ void unpack4(u32x2 w, float (&x)[4]) { x[0] = bflo(w.x); x[1] = bfhi(w.x); x[2] = bflo(w.y); x[3] = bfhi(w.y); }
__device__ __forceinline__ u32x2 pack4(const float (&x)[4]) { u32x2 w; w.x = cvt_pk_bf16(x[0], x[1]); w.y = cvt_pk_bf16(x[2], x[3]); return w; }

__device__ void prep_phase(int wsg, const Params& p) {
    unsigned char* ws = p.ws;
    const bf16_t* __restrict__ PROJ = (const bf16_t*)(ws + OFF_R3);
    bf16_t* __restrict__ LIN = (bf16_t*)(ws + OFF_R1); bf16_t* __restrict__ QN = (bf16_t*)(ws + OFF_R1 + 48 * MiB); bf16_t* __restrict__ KVN = (bf16_t*)(ws + OFF_R1 + 96 * MiB);
    bf16_t* __restrict__ KPE = (bf16_t*)(ws + OFF_R4 + 128 * MiB);
    const float* mu = p.in[I_MU]; const float* qg = p.in[I_QNG]; const float* kvg = p.in[I_KVNG]; const float* rope = (const float*)(ws + OFF_ROPE);
    const int t_ = otid(wsg); const int lane = t_ & 63, wv = blockIdx.x * 8 + (t_ >> 6), nw = gridDim.x * 8;
#pragma unroll 2
    for (int row = wv; row < T_TOK; row += nw) {
        const bf16_t* P = PROJ + (size_t)row * PROJ_LD; const int pos = row & (SEQ - 1); const bool hp = pos != 0; const bf16_t* Pp = P - PROJ_LD;
#pragma unroll
        for (int it = 0; it < 2; ++it) {
            const int idx = it * 256 + lane * 4;
            if (idx < 288) {
                float c[4], pv[4] = {0.f, 0.f, 0.f, 0.f}; unpack4(*(const u32x2*)(P + 1536 + idx), c);
                if (hp) unpack4(*(const u32x2*)(Pp + 1536 + idx), pv);
                const f32x4 m4 = *(const f32x4*)(mu + 1536 + idx);
                float o[4];
#pragma unroll
                for (int e = 0; e < 4; ++e) { const float x = c[e] + m4[e] * (pv[e] - c[e]); o[e] = idx < 64 ? tanhf(x) : (idx < 128 ? x : __builtin_amdgcn_rcpf(1.0f + __expf(-x))); }
                *(u32x2*)(LIN + (size_t)row * 384 + idx) = pack4(o);
            } else if (idx < 384) { u32x2 z; z.x = 0u; z.y = 0u; *(u32x2*)(LIN + (size_t)row * 384 + idx) = z; }
        }
        {
            float a[4], b[4] = {0.f, 0.f, 0.f, 0.f}; unpack4(*(const u32x2*)(P + 1824 + lane * 4), a);
            if (lane < 32) unpack4(*(const u32x2*)(P + 1824 + 256 + lane * 4), b);
            float ss = a[0] * a[0] + a[1] * a[1] + a[2] * a[2] + a[3] * a[3] + b[0] * b[0] + b[1] * b[1] + b[2] * b[2] + b[3] * b[3];
            ss = wave_sum(ss, lane);
            const float r = rsqrtf(ss * (1.0f / 384.0f) + 1e-6f);
            const f32x4 g0 = *(const f32x4*)(qg + lane * 4);
            float o[4];
#pragma unroll
            for (int e = 0; e < 4; ++e) o[e] = a[e] * r * g0[e];
            *(u32x2*)(QN + (size_t)row * 384 + lane * 4) = pack4(o);
            if (lane < 32) { const f32x4 g1 = *(const f32x4*)(qg + 256 + lane * 4);
#pragma unroll
                for (int e = 0; e < 4; ++e) o[e] = b[e] * r * g1[e];
                *(u32x2*)(QN + (size_t)row * 384 + 256 + lane * 4) = pack4(o); }
        }
        {
            float a[4]; unpack4(*(const u32x2*)(P + 2208 + lane * 4), a);
            float ss = a[0] * a[0] + a[1] * a[1] + a[2] * a[2] + a[3] * a[3];
            ss = wave_sum(ss, lane);
            const float r = rsqrtf(ss * (1.0f / 256.0f) + 1e-6f);
            const f32x4 g0 = *(const f32x4*)(kvg + lane * 4);
            float o[4];
#pragma unroll
            for (int e = 0; e < 4; ++e) o[e] = a[e] * r * g0[e];
            *(u32x2*)(KVN + (size_t)row * 256 + lane * 4) = pack4(o);
        }
        if (lane < 16) {
            const float x1 = bf2f(P[2464 + lane]), x2 = bf2f(P[2464 + 16 + lane]);
            const float cs = rope[pos * 16 + lane], sn = rope[8192 * 16 + pos * 16 + lane];
            *(unsigned*)(KPE + (size_t)row * 32 + 2 * lane) = cvt_pk_bf16(x1 * cs - x2 * sn, x2 * cs + x1 * sn);
        }
    }
}

__device__ void attn_phase(int wsg, LAS unsigned char* lds, const bf16_t* Q, const bf16_t* KN, const bf16_t* KPE, const bf16_t* VT, bf16_t* YM, unsigned* counter, const float* rope) {
    constexpr int KSTR = 208, VSTR = 144, KBUF = 64 * KSTR, VBUF = 64 * VSTR, V_OFF0 = 2 * KBUF, ITEM_OFF = V_OFF0 + 3 * VBUF;
    const int tid_ = otid(wsg);
    const int tid = tid_, lane = tid & 63, wid = tid >> 6, l31 = lane & 31, half = lane >> 5;
    volatile LAS int* s_item = (volatile LAS int*)(lds + ITEM_OFF);
    const int xcd = (int)(__builtin_amdgcn_s_getreg((3 << 11) | 20) & 7u);
    for (;;) {
        __syncthreads();
        if (tid == 0) {
            int it = -1;
            for (int s = 0; s < 8 && it < 0; ++s) { const int q = (xcd + s) & 7; const unsigned i = atomicAdd(counter + q * 16, 1u); if (i < 256u) it = q * 256 + (int)i; }
            *s_item = it;
        }
        __syncthreads();
        const int item = *s_item;
        if (item < 0) break;
        const int qi = item & 255, bh = (item >> 8) + 8 * (qi & 7), qb = 31 - (qi >> 3), b = bh >> 3, h = bh & 7;
        const size_t tb = (size_t)b * SEQ;
        const int qrow = qb * 256 + wid * 32 + l31;
        bf16x8 qf[6];
#pragma unroll
        for (int ks = 0; ks < 6; ++ks) qf[ks] = *(const bf16x8*)(Q + (tb + qrow) * 768 + h * 96 + ks * 16 + half * 8);
#pragma unroll
        for (int ks = 4; ks < 6; ++ks) {
            const int p0 = (ks - 4) * 8 + half * 4;
            const f32x4 cs = *(const f32x4*)(rope + qrow * 16 + p0), sn = *(const f32x4*)(rope + 8192 * 16 + qrow * 16 + p0);
            const u32x4 w = __builtin_bit_cast(u32x4, qf[ks]);
            u32x4 o;
            { const float x1 = bflo(w.x), x2 = bfhi(w.x); o.x = cvt_pk_bf16(x1 * cs[0] - x2 * sn[0], x2 * cs[0] + x1 * sn[0]); }
            { const float x1 = bflo(w.y), x2 = bfhi(w.y); o.y = cvt_pk_bf16(x1 * cs[1] - x2 * sn[1], x2 * cs[1] + x1 * sn[1]); }
            { const float x1 = bflo(w.z), x2 = bfhi(w.z); o.z = cvt_pk_bf16(x1 * cs[2] - x2 * sn[2], x2 * cs[2] + x1 * sn[2]); }
            { const float x1 = bflo(w.w), x2 = bfhi(w.w); o.w = cvt_pk_bf16(x1 * cs[3] - x2 * sn[3], x2 * cs[3] + x1 * sn[3]); }
            qf[ks] = __builtin_bit_cast(bf16x8, o);
        }
        const int ntiles = 4 * qb + 4, jmax = 4 * qb + (wid >> 1);
        const int skey = tid >> 3, sseg = tid & 7;
        const bf16_t* gK = KN + (tb + skey) * 512 + h * 64 + sseg * 8;
        const bf16_t* gP = KPE + (tb + ((tid & 255) >> 2)) * 32 + (tid & 3) * 8;
        const bf16_t* gV = VT + ((size_t)((b * 8 + h) * 64 + skey)) * SEQ + sseg * 8;
        const unsigned lK = skey * KSTR + sseg * 16, lP = (tid >> 2) * KSTR + 128 + (tid & 3) * 16, lV = V_OFF0 + skey * VSTR + (sseg >> 1) * 32 + (sseg & 1) * 8;
        u32x4 rK = *(const u32x4*)gK, rP = (u32x4){0u, 0u, 0u, 0u}, rV = *(const u32x4*)gV;
        rP = *(const u32x4*)gP;
        *(LAS u32x4*)(lds + lK) = rK; if (tid < 256) *(LAS u32x4*)(lds + lP) = rP; *(LAS u32x2*)(lds + lV) = (u32x2){rV.x, rV.y}; *(LAS u32x2*)(lds + lV + 16) = (u32x2){rV.z, rV.w};
        rK = *(const u32x4*)(gK + (size_t)64 * 512); rV = *(const u32x4*)(gV + 64); rP = *(const u32x4*)(gP + (size_t)64 * 32);
        u32x4 nK = rK, nP = rP, nV = rV;
        __syncthreads();
        f32x16 ot[2], st[2];
#pragma unroll
        for (int i = 0; i < 16; ++i) { ot[0][i] = 0.f; ot[1][i] = 0.f; st[0][i] = 0.f; st[1][i] = 0.f; }
        float mrun = 0.f, lrun = 0.f;
        auto QK = [&](int jt) {
            const float negm = -mrun;
#pragma unroll
            for (int i = 0; i < 16; ++i) { st[0][i] = negm; st[1][i] = negm; }
            const LAS unsigned char* kb = lds + (jt & 1) * KBUF + l31 * KSTR + half * 16;
#pragma unroll
            for (int ks = 0; ks < 6; ++ks)
#pragma unroll
                for (int kt = 0; kt < 2; ++kt) {
                    const bf16x8 a = *(const LAS bf16x8*)(kb + kt * 32 * KSTR + ks * 32);
                    st[kt] = __builtin_amdgcn_mfma_f32_32x32x16_bf16(a, qf[ks], st[kt], 0, 0, 0);
                }
        };
        auto SMPV = [&](int jt) {
            float mx = fmaxf(st[0][0], st[1][0]);
#pragma unroll
            for (int i = 1; i < 16; ++i) mx = fmaxf(fmaxf(mx, st[0][i]), st[1][i]);
            mx = fmaxf(mx, shx(mx, lane, 32));
            const bool slow = (jt == 0) || (__builtin_amdgcn_ballot_w64(mx > 8.0f) != 0ull);
            if (slow) {
                const float delta = (jt == 0 || mx > 0.f) ? mx : 0.f;
                const float alpha = __builtin_amdgcn_exp2f(-delta);
                mrun += delta; lrun *= alpha;
#pragma unroll
                for (int i = 0; i < 16; ++i) { ot[0][i] *= alpha; ot[1][i] *= alpha; st[0][i] -= delta; st[1][i] -= delta; }
            }
            float rs = 0.f;
#pragma unroll
            for (int kt = 0; kt < 2; ++kt)
#pragma unroll
                for (int i = 0; i < 16; ++i) { const float pe = __builtin_amdgcn_exp2f(st[kt][i]); st[kt][i] = pe; rs += pe; }
            lrun += rs;
            bf16x8 pf[2][2];
#pragma unroll
            for (int kt = 0; kt < 2; ++kt)
#pragma unroll
                for (int s2 = 0; s2 < 2; ++s2) {
                    u32x4 w; w.x = cvt_pk_bf16(st[kt][8 * s2 + 0], st[kt][8 * s2 + 1]); w.y = cvt_pk_bf16(st[kt][8 * s2 + 2], st[kt][8 * s2 + 3]);
                    w.z = cvt_pk_bf16(st[kt][8 * s2 + 4], st[kt][8 * s2 + 5]); w.w = cvt_pk_bf16(st[kt][8 * s2 + 6], st[kt][8 * s2 + 7]);
                    pf[kt][s2] = __builtin_bit_cast(bf16x8, w);
                }
            __builtin_amdgcn_sched_barrier(0);
            const LAS unsigned char* vb = lds + V_OFF0 + (jt % 3) * VBUF + l31 * VSTR + half * 16;
#pragma unroll
            for (int dvt = 0; dvt < 2; ++dvt)
#pragma unroll
                for (int kt = 0; kt < 2; ++kt)
#pragma unroll
                    for (int s2 = 0; s2 < 2; ++s2) {
                        const LAS unsigned char* vp = vb + dvt * 32 * VSTR + (kt * 32 + s2 * 16) * 2;
                        const bf16x8 av = *(const LAS bf16x8*)vp;
                        ot[dvt] = __builtin_amdgcn_mfma_f32_32x32x16_bf16(av, pf[kt][s2], ot[dvt], 0, 0, 0);
                    }
        };
        const bool late = wid >= 4;
        if (late) __builtin_amdgcn_s_setprio(1);
        auto step = [&](int j, u32x4& aK, u32x4& aP, u32x4& aV, u32x4& bK, u32x4& bP, u32x4& bV) {
            if (j + 2 < ntiles) {
                bK = *(const u32x4*)(gK + (size_t)(j + 2) * 64 * 512); bV = *(const u32x4*)(gV + (j + 2) * 64); bP = *(const u32x4*)(gP + (size_t)(j + 2) * 64 * 32);
            }
            if (!late) {
                if (j < ntiles && j <= jmax) { QK(j); __builtin_amdgcn_sched_barrier(0); SMPV(j); }
            } else {
                if (j >= 1 && j - 1 <= jmax) SMPV(j - 1);
                __builtin_amdgcn_sched_barrier(0);
                if (j < ntiles && j <= jmax) QK(j);
            }
            if (j + 1 < ntiles) {
                const unsigned kofs = (unsigned)((j + 1) & 1) * KBUF, vofs = (unsigned)((j + 1) % 3) * VBUF;
                *(LAS u32x4*)(lds + kofs + lK) = aK; if (tid < 256) *(LAS u32x4*)(lds + kofs + lP) = aP; *(LAS u32x2*)(lds + vofs + lV) = (u32x2){aV.x, aV.y}; *(LAS u32x2*)(lds + vofs + lV + 16) = (u32x2){aV.z, aV.w};
            }
            __syncthreads();
        };
        for (int j = 0; j <= ntiles; j += 2) {
            step(j, rK, rP, rV, nK, nP, nV);
            if (j + 1 <= ntiles) step(j + 1, nK, nP, nV, rK, rP, rV);
        }
        __builtin_amdgcn_s_setprio(0);
        lrun += shx(lrun, lane, 32);
        const float inv = 1.0f / lrun;
        bf16_t* op = YM + (tb + qrow) * 512 + h * 64 + half * 4;
#pragma unroll
        for (int dvt = 0; dvt < 2; ++dvt)
#pragma unroll
            for (int g = 0; g < 4; ++g) {
                u32x2 w; w.x = cvt_pk_bf16(ot[dvt][4 * g] * inv, ot[dvt][4 * g + 1] * inv); w.y = cvt_pk_bf16(ot[dvt][4 * g + 2] * inv, ot[dvt][4 * g + 3] * inv);
                *(u32x2*)(op + dvt * 32 + g * 8) = w;
            }
    }
}

constexpr int MS = 144;
constexpr int MB = 64 * MS;
constexpr int SC_KT = 0, SC_BT = MB, SC_QK = 2 * MB, SC_RT = 3 * MB, SC_KH = 4 * MB, SC_BH = 5 * MB, SC_VM = 6 * MB, SC_S0 = 7 * MB,
              SC_MK = 8 * MB, SC_AK = 9 * MB, SC_AB = 10 * MB, SC_RHS = 11 * MB, SC_NT = 12 * MB  , SC_MISC = SC_NT + 64 * 68 * 4;
constexpr int SC_TT = SC_KT, SC_UN = SC_MK, SC_YF = SC_NT;
constexpr int SS = 80;
constexpr int SC_N12 = SC_BT, SC_XT = SC_BT + 32 * SS, SC_T11 = SC_BT + 64 * SS;
static_assert(SC_MISC + 1024 <= LDS_MAIN, "scan LDS overflow");

template <int KS, bool SWA = false, bool SWB = false>
__device__ __forceinline__ f32x16 mm_tile(f32x16 acc, const LAS unsigned char* A, int arow0, const LAS unsigned char* B, int brow0, int l31, int half) {
    const int ra = arow0 + l31, rb = brow0 + l31;
    const LAS unsigned char* ap = A + ra * MS;
    const LAS unsigned char* bp = B + rb * MS;
    const int sa = SWA ? ((ra >> 3) & 7) : 0, sb = SWB ? ((rb >> 3) & 7) : 0;
#pragma unroll
    for (int ks = 0; ks < KS; ++ks) {
        const int q = ks * 2 + half;
        acc = __builtin_amdgcn_mfma_f32_32x32x16_bf16(*(const LAS bf16x8*)(ap + ((q ^ sa) << 4)), *(const LAS bf16x8*)(bp + ((q ^ sb) << 4)), acc, 0, 0, 0);
    }
    return acc;
}
__device__ __forceinline__ void store_tile_nm(LAS unsigned char* D, int nrow0, int mcol0, const f32x16& acc, int l31, int half, float sc, int stride = MS) {
    LAS unsigned char* dp = D + (nrow0 + l31) * stride + (mcol0 + half * 4) * 2;
#pragma unroll
    for (int g = 0; g < 4; ++g) { u32x2 w; w.x = cvt_pk_bf16(acc[4 * g] * sc, acc[4 * g + 1] * sc); w.y = cvt_pk_bf16(acc[4 * g + 2] * sc, acc[4 * g + 3] * sc); *(LAS u32x2*)(dp + g * 16) = w; }
}
__device__ __forceinline__ f32x16 zero16() { f32x16 z;
#pragma unroll
    for (int i = 0; i < 16; ++i) z[i] = 0.f; return z; }

__device__ void scan_chain(int wsg, LAS unsigned char* lds, const Params& p, int chain) {
    unsigned char* ws = p.ws;
    const bf16_t* PROJ = (const bf16_t*)(ws + OFF_R3);
    const unsigned short* WAG = (const unsigned short*)(ws + OFF_R2);
    bf16_t* YR = (bf16_t*)(ws + OFF_R1);
    const int tid0 = otid(wsg), wid = __builtin_amdgcn_readfirstlane(tid0 >> 6);
    const int b = chain >> 3, h = chain & 7;
    for (int i = tid0; i < MB / 4; i += 512) *(LAS unsigned*)(lds + SC_S0 + i * 4) = 0u;
    f32x16 st = zero16();
    const size_t tok0 = (size_t)b * SEQ;
    u32x4 cr, ck, cv, pr, pk, pv, ce, ca, cg;
    auto prefetch = [&](int c, int tl, int hc) {
        const size_t tok = tok0 + (size_t)c * 64 + tl;
        const bf16_t* P = PROJ + tok * PROJ_LD + hc;
        cr = *(const u32x4*)P; ck = *(const u32x4*)(P + 512); cv = *(const u32x4*)(P + 1024);
        if (c * 64 + tl > 0) { pr = *(const u32x4*)(P - PROJ_LD); pk = *(const u32x4*)(P - PROJ_LD + 512); pv = *(const u32x4*)(P - PROJ_LD + 1024); }
        else { pr = (u32x4){0u, 0u, 0u, 0u}; pk = pr; pv = pr; }
        const unsigned short* W = WAG + tok * 1536 + hc;
        ce = *(const u32x4*)W; ca = *(const u32x4*)(W + 512); cg = *(const u32x4*)(W + 1024);
    };
    prefetch(0, tid0 >> 3, h * 64 + (tid0 & 7) * 8);
    LAS float* NT = (LAS float*)(lds + SC_NT);
    LAS float* WC = (LAS float*)(lds + SC_MISC);
#pragma unroll 1
    for (int c = 0; c < SEQ / 64; ++c) {
        int tid = tid0; asm volatile("" : "+v"(tid));
        const int lane = tid & 63, l31 = lane & 31, half = lane >> 5;
        const int tl = tid >> 3, kseg = tid & 7, k0 = kseg * 8, hc = h * 64 + k0;
        float r_[8], k_[8], v_[8], e_[8], a_[8], g_[8];
        {
            float mu_r[8], mu_k[8], mu_v[8];
            { const f32x4 a0 = *(const f32x4*)(p.in[I_MU] + hc), a1 = *(const f32x4*)(p.in[I_MU] + hc + 4), b0 = *(const f32x4*)(p.in[I_MU] + 512 + hc), b1 = *(const f32x4*)(p.in[I_MU] + 512 + hc + 4),
                          c0 = *(const f32x4*)(p.in[I_MU] + 1024 + hc), c1 = *(const f32x4*)(p.in[I_MU] + 1024 + hc + 4);
#pragma unroll
              for (int e = 0; e < 4; ++e) { mu_r[e] = a0[e]; mu_r[4 + e] = a1[e]; mu_k[e] = b0[e]; mu_k[4 + e] = b1[e]; mu_v[e] = c0[e]; mu_v[4 + e] = c1[e]; } }
            const unsigned wr_[4] = {cr.x, cr.y, cr.z, cr.w}, wk_[4] = {ck.x, ck.y, ck.z, ck.w}, wv_[4] = {cv.x, cv.y, cv.z, cv.w};
            const unsigned xr_[4] = {pr.x, pr.y, pr.z, pr.w}, xk_[4] = {pk.x, pk.y, pk.z, pk.w}, xv_[4] = {pv.x, pv.y, pv.z, pv.w};
            const unsigned we_[4] = {ce.x, ce.y, ce.z, ce.w}, wa_[4] = {ca.x, ca.y, ca.z, ca.w}, wg_[4] = {cg.x, cg.y, cg.z, cg.w};
#pragma unroll
            for (int q = 0; q < 4; ++q) {
                float c0 = bflo(wr_[q]), c1 = bfhi(wr_[q]); r_[2 * q] = c0 + mu_r[2 * q] * (bflo(xr_[q]) - c0); r_[2 * q + 1] = c1 + mu_r[2 * q + 1] * (bfhi(xr_[q]) - c1);
                c0 = bflo(wk_[q]); c1 = bfhi(wk_[q]); k_[2 * q] = c0 + mu_k[2 * q] * (bflo(xk_[q]) - c0); k_[2 * q + 1] = c1 + mu_k[2 * q + 1] * (bfhi(xk_[q]) - c1);
                c0 = bflo(wv_[q]); c1 = bfhi(wv_[q]); v_[2 * q] = c0 + mu_v[2 * q] * (bflo(xv_[q]) - c0); v_[2 * q + 1] = c1 + mu_v[2 * q + 1] * (bfhi(xv_[q]) - c1);
                e_[2 * q] = f16lo(we_[q]); e_[2 * q + 1] = f16hi(we_[q]); a_[2 * q] = f16lo(wa_[q]); a_[2 * q + 1] = f16hi(wa_[q]); g_[2 * q] = f16lo(wg_[q]); g_[2 * q + 1] = f16hi(wg_[q]);
            }
        }
        if (c + 1 < SEQ / 64) prefetch(c + 1, tl, hc);
        float kk_[8], bb_[8], bonus = 0.f;
        {
            float kkc[8], kac[8], rkc[8];
            { const f32x4 a0 = *(const f32x4*)(p.in[I_KK] + hc), a1 = *(const f32x4*)(p.in[I_KK] + hc + 4), b0 = *(const f32x4*)(p.in[I_KA] + hc), b1 = *(const f32x4*)(p.in[I_KA] + hc + 4),
                          c0 = *(const f32x4*)(p.in[I_RK] + hc), c1 = *(const f32x4*)(p.in[I_RK] + hc + 4);
#pragma unroll
              for (int e = 0; e < 4; ++e) { kkc[e] = a0[e]; kkc[4 + e] = a1[e]; kac[e] = b0[e]; kac[4 + e] = b1[e]; rkc[e] = c0[e]; rkc[4 + e] = c1[e]; } }
            float ss = 0.f;
#pragma unroll
            for (int e = 0; e < 8; ++e) { kk_[e] = k_[e] * kkc[e]; ss += kk_[e] * kk_[e]; }
            ss += shx(ss, lane, 1); ss += shx(ss, lane, 2); ss += shx(ss, lane, 4);
            const float rn = rsqrtf(fmaxf(ss, 1e-24f));
#pragma unroll
            for (int e = 0; e < 8; ++e) { kk_[e] *= rn; k_[e] = k_[e] * (1.0f + (a_[e] - 1.0f) * kac[e]); bb_[e] = kk_[e] * a_[e]; bonus += r_[e] * k_[e] * rkc[e]; }
            bonus += shx(bonus, lane, 1); bonus += shx(bonus, lane, 2); bonus += shx(bonus, lane, 4);
        }
        float L[8], Lm[8], LC[8];
        {
#pragma unroll
            for (int e = 0; e < 8; ++e) L[e] = -e_[e];
            const int jj = lane >> 3;
#pragma unroll
            for (int d = 1; d < 8; d <<= 1) {
#pragma unroll
                for (int e = 0; e < 8; ++e) { const float y = __int_as_float(__builtin_amdgcn_ds_bpermute((lane - 8 * d) << 2, __float_as_int(L[e]))); L[e] += (jj >= d) ? y : 0.f; }
            }
            LAS float* TOT = (LAS float*)(lds + SC_RHS);
            if (jj == 7) { *(LAS f32x4*)(TOT + wid * 64 + k0) = (f32x4){L[0], L[1], L[2], L[3]}; *(LAS f32x4*)(TOT + wid * 64 + k0 + 4) = (f32x4){L[4], L[5], L[6], L[7]}; }
            __syncthreads();
            float off[8];
#pragma unroll
            for (int e = 0; e < 8; ++e) { off[e] = 0.f; LC[e] = 0.f; }
#pragma unroll
            for (int w = 0; w < 8; ++w) {
                const f32x4 t0 = *(const LAS f32x4*)(TOT + w * 64 + k0), t1 = *(const LAS f32x4*)(TOT + w * 64 + k0 + 4);
                const float tv[8] = {t0[0], t0[1], t0[2], t0[3], t1[0], t1[1], t1[2], t1[3]};
#pragma unroll
                for (int e = 0; e < 8; ++e) { LC[e] += tv[e]; off[e] += (w < wid) ? tv[e] : 0.f; }
            }
#pragma unroll
            for (int e = 0; e < 8; ++e) { L[e] += off[e]; Lm[e] = L[e] + e_[e]; }
            if (tl == 63) { *(LAS f32x4*)(WC + k0) = (f32x4){__expf(LC[0]), __expf(LC[1]), __expf(LC[2]), __expf(LC[3])}; *(LAS f32x4*)(WC + k0 + 4) = (f32x4){__expf(LC[4]), __expf(LC[5]), __expf(LC[6]), __expf(LC[7])}; }
        }
        {
            float qk[8], rt[8], kt[8], bt[8], kh[8], bh[8];
#pragma unroll
            for (int e = 0; e < 8; ++e) {
                const float el = __expf(L[e]), elm = __expf(Lm[e]), ei = __expf(-L[e]), ec = __expf(LC[e] - L[e]);
                qk[e] = kk_[e] * elm; rt[e] = r_[e] * el; kt[e] = k_[e] * ei; bt[e] = bb_[e] * ei; kh[e] = k_[e] * ec; bh[e] = bb_[e] * ec;
            }
            u32x4 w;
            w.x = cvt_pk_bf16(qk[0], qk[1]); w.y = cvt_pk_bf16(qk[2], qk[3]); w.z = cvt_pk_bf16(qk[4], qk[5]); w.w = cvt_pk_bf16(qk[6], qk[7]); *(LAS u32x4*)(lds + SC_QK + tl * MS + k0 * 2) = w;
            w.x = cvt_pk_bf16(rt[0], rt[1]); w.y = cvt_pk_bf16(rt[2], rt[3]); w.z = cvt_pk_bf16(rt[4], rt[5]); w.w = cvt_pk_bf16(rt[6], rt[7]); *(LAS u32x4*)(lds + SC_RT + tl * MS + k0 * 2) = w;
            w.x = cvt_pk_bf16(kt[0], kt[1]); w.y = cvt_pk_bf16(kt[2], kt[3]); w.z = cvt_pk_bf16(kt[4], kt[5]); w.w = cvt_pk_bf16(kt[6], kt[7]); *(LAS u32x4*)(lds + SC_KT + tl * MS + k0 * 2) = w;
            w.x = cvt_pk_bf16(bt[0], bt[1]); w.y = cvt_pk_bf16(bt[2], bt[3]); w.z = cvt_pk_bf16(bt[4], bt[5]); w.w = cvt_pk_bf16(bt[6], bt[7]); *(LAS u32x4*)(lds + SC_BT + tl * MS + k0 * 2) = w;
#pragma unroll
            for (int e = 0; e < 8; ++e) {
                const int toff = (k0 + e) * MS + ((wid ^ kseg) << 4) + (tl & 7) * 2;
                *(LAS bf16_t*)(lds + SC_KH + toff) = (bf16_t)(cvt_pk_bf16(kh[e], 0.f) & 0xffffu);
                *(LAS bf16_t*)(lds + SC_BH + toff) = (bf16_t)(cvt_pk_bf16(bh[e], 0.f) & 0xffffu);
                *(LAS bf16_t*)(lds + SC_VM + toff) = (bf16_t)(cvt_pk_bf16(v_[e], 0.f) & 0xffffu);
            }
        }
        __syncthreads();
#pragma unroll
        for (int q = 0; q < 2; ++q) {
            const int tile = wid * 2 + q, mi = tile >> 2, ni = tile & 3;
            const int ib = (mi & 1) * 32, tb = (ni & 1) * 32;
            if (ib > tb) {
                if (!(mi >= 2 && ni < 2)) { LAS unsigned char* D = lds + (mi < 2 ? (ni < 2 ? SC_MK : SC_AK) : SC_AB); store_tile_nm(D, tb, ib, zero16(), l31, half, 0.f); }
                else {
#pragma unroll
                    for (int i = 0; i < 16; ++i) NT[(tb + l31) * 68 + ib + 8 * (i >> 2) + 4 * half + (i & 3)] = 0.f; }
                continue;
            }
            f32x16 acc = mm_tile<4>(zero16(), lds + SC_KT, mi * 32, lds + SC_QK, ni * 32, l31, half);
            const bool strict = (ni < 2);
#pragma unroll
            for (int i = 0; i < 16; ++i) { const int ii = ib + 8 * (i >> 2) + 4 * half + (i & 3), tt = tb + l31; const bool keep = strict ? (ii < tt) : (ii <= tt); acc[i] = keep ? acc[i] : 0.f; }
            if (mi >= 2 && ni < 2) {
#pragma unroll
                for (int i = 0; i < 16; ++i) NT[(tb + l31) * 68 + ib + 8 * (i >> 2) + 4 * half + (i & 3)] = acc[i];
            } else { LAS unsigned char* D = lds + (mi < 2 ? (ni < 2 ? SC_MK : SC_AK) : SC_AB); store_tile_nm(D, tb, ib, acc, l31, half, 1.0f); }
        }
        __syncthreads();
        if (wid == 0) {
            const int base = half * 32;
            float Tj[32];
            f32x4 cur[8], nxt[8];
#pragma unroll
            for (int q = 0; q < 8; ++q) { cur[q] = (f32x4){0.f, 0.f, 0.f, 0.f}; nxt[q] = cur[q]; }
#pragma unroll
            for (int tt = 0; tt < 32; ++tt) {
                if (tt + 1 < 32) {
#pragma unroll
                    for (int i4 = 0; i4 < (tt + 1 + 3) / 4; ++i4) nxt[i4] = *(const LAS f32x4*)(NT + (base + tt + 1) * 68 + base + i4 * 4);
                }
                __builtin_amdgcn_sched_barrier(0);
                float s0 = (l31 == tt) ? 1.0f : 0.0f, s1 = 0.f;
#pragma unroll
                for (int ii = 0; ii < tt; ++ii) { if (ii & 1) s1 -= Tj[ii] * cur[ii >> 2][ii & 3]; else s0 -= Tj[ii] * cur[ii >> 2][ii & 3]; }
                Tj[tt] = s0 + s1;
                __builtin_amdgcn_sched_barrier(0);
#pragma unroll
                for (int q = 0; q < 8; ++q) cur[q] = nxt[q];
            }
#pragma unroll
            for (int tt = 0; tt < 32; ++tt) *(LAS bf16_t*)(lds + SC_TT + (base + tt) * MS + (base + l31) * 2) = (bf16_t)(cvt_pk_bf16(Tj[tt], 0.f) & 0xffffu);
            {
                LAS unsigned char* zp = lds + SC_TT + l31 * MS + 64 + half * 32;
                *(LAS u32x4*)zp = (u32x4){0u, 0u, 0u, 0u}; *(LAS u32x4*)(zp + 16) = (u32x4){0u, 0u, 0u, 0u};
            }
            if (half == 0) {
#pragma unroll
                for (int q = 0; q < 4; ++q) { u32x4 w; w.x = cvt_pk_bf16(Tj[8 * q], Tj[8 * q + 1]); w.y = cvt_pk_bf16(Tj[8 * q + 2], Tj[8 * q + 3]); w.z = cvt_pk_bf16(Tj[8 * q + 4], Tj[8 * q + 5]); w.w = cvt_pk_bf16(Tj[8 * q + 6], Tj[8 * q + 7]);
                    *(LAS u32x4*)(lds + SC_T11 + l31 * SS + q * 16) = w; }
            }
            {
                float nv[16];
#pragma unroll
                for (int s = 0; s < 16; ++s) nv[s] = NT[(32 + half * 16 + s) * 68 + l31];
                u32x4 w; w.x = cvt_pk_bf16(nv[0], nv[1]); w.y = cvt_pk_bf16(nv[2], nv[3]); w.z = cvt_pk_bf16(nv[4], nv[5]); w.w = cvt_pk_bf16(nv[6], nv[7]);
                *(LAS u32x4*)(lds + SC_N12 + l31 * SS + half * 32) = w;
                w.x = cvt_pk_bf16(nv[8], nv[9]); w.y = cvt_pk_bf16(nv[10], nv[11]); w.z = cvt_pk_bf16(nv[12], nv[13]); w.w = cvt_pk_bf16(nv[14], nv[15]);
                *(LAS u32x4*)(lds + SC_N12 + l31 * SS + half * 32 + 16) = w;
            }
            __builtin_amdgcn_fence(__ATOMIC_RELEASE, "workgroup"); __builtin_amdgcn_wave_barrier();
            {
                f32x16 x = zero16();
                const LAS unsigned char* ap = lds + SC_N12 + l31 * SS + half * 16;
                const LAS unsigned char* bp = lds + SC_TT + (32 + l31) * MS + (32 + half * 8) * 2;
#pragma unroll
                for (int ks = 0; ks < 2; ++ks) x = __builtin_amdgcn_mfma_f32_32x32x16_bf16(*(const LAS bf16x8*)(ap + ks * 32), *(const LAS bf16x8*)(bp + ks * 32), x, 0, 0, 0);
                store_tile_nm(lds + SC_XT, 0, 0, x, l31, half, 1.0f, SS);
            }
            __builtin_amdgcn_fence(__ATOMIC_RELEASE, "workgroup"); __builtin_amdgcn_wave_barrier();
            {
                f32x16 x = zero16();
                const LAS unsigned char* ap = lds + SC_T11 + l31 * SS + half * 16;
                const LAS unsigned char* bp = lds + SC_XT + l31 * SS + half * 16;
#pragma unroll
                for (int ks = 0; ks < 2; ++ks) x = __builtin_amdgcn_mfma_f32_32x32x16_bf16(*(const LAS bf16x8*)(ap + ks * 32), *(const LAS bf16x8*)(bp + ks * 32), x, 0, 0, 0);
                store_tile_nm(lds + SC_TT, 32, 0, x, l31, half, -1.0f);
            }
        } else if (wid >= 4) {
            const int tbk = ((wid - 4) >> 1) * 32, vbk = ((wid - 4) & 1) * 32;
            f32x16 acc = mm_tile<4>(zero16(), lds + SC_QK, tbk, lds + SC_S0, vbk, l31, half);
            acc = mm_tile<4, false, true>(acc, lds + SC_MK, tbk, lds + SC_VM, vbk, l31, half);
            store_tile_nm(lds + SC_RHS, vbk, tbk, acc, l31, half, 1.0f);
        }
        __syncthreads();
        if (wid < 4) {
            const int tbk = (wid >> 1) * 32, vbk = (wid & 1) * 32;
            f32x16 acc = mm_tile<4>(zero16(), lds + SC_TT, tbk, lds + SC_RHS, vbk, l31, half);
            store_tile_nm(lds + SC_UN, vbk, tbk, acc, l31, half, -1.0f);
        }
        __syncthreads();
        if (wid < 4) {
            const int kbk = (wid >> 1) * 32, vbk = (wid & 1) * 32;
#pragma unroll
            for (int i = 0; i < 16; ++i) st[i] *= WC[kbk + 8 * (i >> 2) + 4 * half + (i & 3)];
            st = mm_tile<4, true, true>(st, lds + SC_KH, kbk, lds + SC_VM, vbk, l31, half);
            st = mm_tile<4, true, false>(st, lds + SC_BH, kbk, lds + SC_UN, vbk, l31, half);
        } else {
            const int vbk = ((wid - 4) >> 1) * 32, tbk = ((wid - 4) & 1) * 32;
            f32x16 acc = mm_tile<4>(zero16(), lds + SC_S0, vbk, lds + SC_RT, tbk, l31, half);
            acc = mm_tile<4, true, false>(acc, lds + SC_VM, vbk, lds + SC_AK, tbk, l31, half);
            acc = mm_tile<4>(acc, lds + SC_UN, vbk, lds + SC_AB, tbk, l31, half);
            LAS float* yp = (LAS float*)(lds + SC_YF) + (tbk + l31) * 68 + vbk + half * 4;
#pragma unroll
            for (int g = 0; g < 4; ++g) *(LAS f32x4*)(yp + g * 8) = (f32x4){acc[4 * g], acc[4 * g + 1], acc[4 * g + 2], acc[4 * g + 3]};
        }
        __syncthreads();
        if (wid < 4) { const int kbk = (wid >> 1) * 32, vbk = (wid & 1) * 32; store_tile_nm(lds + SC_S0, vbk, kbk, st, l31, half, 1.0f); }
        {
            const LAS float* yp = (const LAS float*)(lds + SC_YF) + tl * 68 + k0;
            const f32x4 y0 = *(const LAS f32x4*)yp, y1 = *(const LAS f32x4*)(yp + 4);
            float y[8] = {y0[0], y0[1], y0[2], y0[3], y1[0], y1[1], y1[2], y1[3]};
            float s = y[0] + y[1] + y[2] + y[3] + y[4] + y[5] + y[6] + y[7];
            s += shx(s, lane, 1); s += shx(s, lane, 2); s += shx(s, lane, 4);
            const float mu = s * (1.0f / 64.0f);
            float q = 0.f;
#pragma unroll
            for (int e = 0; e < 8; ++e) { y[e] -= mu; q += y[e] * y[e]; }
            q += shx(q, lane, 1); q += shx(q, lane, 2); q += shx(q, lane, 4);
            const float rs = rsqrtf(q * (1.0f / 64.0f) + 64e-5f);
            float gng[8], gnb[8];
            { const f32x4 a0 = *(const f32x4*)(p.in[I_GNG] + hc), a1 = *(const f32x4*)(p.in[I_GNG] + hc + 4), b0 = *(const f32x4*)(p.in[I_GNB] + hc), b1 = *(const f32x4*)(p.in[I_GNB] + hc + 4);
#pragma unroll
              for (int e = 0; e < 4; ++e) { gng[e] = a0[e]; gng[4 + e] = a1[e]; gnb[e] = b0[e]; gnb[4 + e] = b1[e]; } }
            float o[8];
#pragma unroll
            for (int e = 0; e < 8; ++e) o[e] = (y[e] * rs * gng[e] + gnb[e] + bonus * v_[e]) * g_[e];
            u32x4 w; w.x = cvt_pk_bf16(o[0], o[1]); w.y = cvt_pk_bf16(o[2], o[3]); w.z = cvt_pk_bf16(o[4], o[5]); w.w = cvt_pk_bf16(o[6], o[7]);
            *(u32x4*)(YR + (tok0 + (size_t)c * 64 + tl) * 512 + hc) = w;
        }
    }
    __syncthreads();
}

#define XB_TMO      128
#define XB_XCNT(j)  (256  + 64 * (j))
#define XB_XSUB(j)  (1280 + 64 * (j))
#define XB_XGEN(j)  (2304 + 64 * (j))
#define XB_TOP      3328
#define XB_TOPGEN   3392
#define XCD_BAR_WORDS 3456
#define XB_SPIN_CAP (1u << 18)

__device__ __forceinline__ unsigned xb_ld(unsigned* p)              { return __hip_atomic_load(p, __ATOMIC_RELAXED, __HIP_MEMORY_SCOPE_AGENT); }
__device__ __forceinline__ unsigned xb_add(unsigned* p, unsigned v) { return __hip_atomic_fetch_add(p, v, __ATOMIC_RELAXED, __HIP_MEMORY_SCOPE_AGENT); }
__device__ __forceinline__ unsigned xb_xcc_id() { return (unsigned)__builtin_amdgcn_s_getreg((3 << 11) | 20) & 0xFu; }
#define XB_SPIN(cond, bar) do { unsigned _sp = 0; while (cond) { __builtin_amdgcn_s_sleep(1); \
    if ((++_sp & 255u) == 0u) { if (xb_ld(&(bar)[XB_TMO])) break; if (_sp > XB_SPIN_CAP) { atomicAdd(&(bar)[XB_TMO], 1u); break; } } } } while (0)

struct XcdBarrier {
    unsigned* bar; unsigned x;
    volatile LAS unsigned* st;
};

__device__ __forceinline__ XcdBarrier xcd_barrier_post(unsigned* bar, volatile LAS unsigned* st) {
    XcdBarrier b; b.bar = bar; b.x = xb_xcc_id(); b.st = st;
    if (threadIdx.x == 0) (void)xb_add(&bar[XB_XCNT(b.x)], 1u);
    return b;
}
__device__ __forceinline__ void xcd_barrier_complete(unsigned* bar, unsigned x, unsigned& nloc, unsigned& nx) {
    const unsigned G = gridDim.x * gridDim.y * gridDim.z;
    unsigned sum, cnt, mine, sp = 0u;
    for (;;) {
        sum = 0u; cnt = 0u; mine = 0u;
#pragma unroll
        for (unsigned j = 0; j < 16; ++j) { const unsigned c = xb_ld(&bar[XB_XCNT(j)]); sum += c; cnt += (c > 0u) ? 1u : 0u; mine = (j == x) ? c : mine; }
        if (sum == G) break;
        __builtin_amdgcn_s_sleep(1);
        if ((++sp & 255u) == 0u) { if (xb_ld(&bar[XB_TMO])) break; if (sp > XB_SPIN_CAP) { atomicAdd(&bar[XB_TMO], 1u); break; } }
    }
    nloc = mine > 0u ? mine : 1u; nx = cnt > 0u ? cnt : 1u;
}

__device__ __forceinline__ void xcd_barrier(const XcdBarrier& b) {
    asm volatile("s_waitcnt vmcnt(0)" ::: "memory");
    __syncthreads();
    if (threadIdx.x == 0) {
        unsigned* bar = b.bar;
        __builtin_amdgcn_s_waitcnt(0);
        unsigned nloc = b.st[0], nx = b.st[1];
        if (nloc == 0u) { xcd_barrier_complete(bar, b.x, nloc, nx); b.st[0] = nloc; b.st[1] = nx; }
        const unsigned old = xb_add(&bar[XB_XSUB(b.x)], 1u);
        const unsigned gen = old / nloc;
        if (old + 1u == (gen + 1u) * nloc) {
            __builtin_amdgcn_fence(__ATOMIC_RELEASE, "agent");
            asm volatile("s_waitcnt vmcnt(0)" ::: "memory");
            const unsigned og = xb_add(&bar[XB_TOP], 1u);
            const unsigned tg = og / nx;
            if (og + 1u == (tg + 1u) * nx) xb_add(&bar[XB_TOPGEN], 1u);
            else XB_SPIN(xb_ld(&bar[XB_TOPGEN]) == tg, bar);
            __builtin_amdgcn_fence(__ATOMIC_ACQUIRE, "agent");
            xb_add(&bar[XB_XGEN(b.x)], 1u);
            asm volatile("s_waitcnt vmcnt(0)" ::: "memory");
        } else {
            XB_SPIN(xb_ld(&bar[XB_XGEN(b.x)]) == gen, bar);
            __builtin_amdgcn_fence(__ATOMIC_ACQUIRE, "agent");
            asm volatile("s_waitcnt vmcnt(0)" ::: "memory");
        }
    }
    __syncthreads();
}

typedef const __attribute__((address_space(4))) Params* kparams_t;
__device__ __forceinline__ Params load_params(kparams_t q) { Params r;
#pragma unroll
    for (int i = 0; i < 32; ++i) r.in[i] = q->in[i];
    r.out = q->out; r.ws = q->ws; return r; }
__global__ void __launch_bounds__(512, 2) mk_fwd(Params p_unused) {
    extern __shared__ __attribute__((aligned(16))) unsigned char shm[];
    LAS unsigned char* lds = (LAS unsigned char*)shm;
    int wsg = __builtin_amdgcn_readfirstlane((int)threadIdx.x >> 6); asm volatile("" : "+s"(wsg));
    kparams_t pp = (kparams_t)__builtin_amdgcn_kernarg_segment_ptr();
#define PQ_ ({ asm volatile("" : "+s"(pp)); pp; })
#define P_ (*PQ_)
    unsigned char* ws = P_.ws;
    volatile LAS unsigned* xst = (volatile LAS unsigned*)(lds + LDS_MAIN);
    if (threadIdx.x < 2) xst[threadIdx.x] = 0u;
    __syncthreads();
    (void)xcd_barrier_post((unsigned*)(ws + OFF_BAR), xst);
#define GSYNC() do { XcdBarrier xb_; xb_.bar = (unsigned*)(P_.ws + OFF_BAR); xb_.x = xb_xcc_id(); xb_.st = xst; xcd_barrier(xb_); } while (0)
    bf16_t* actb = (bf16_t*)(ws + OFF_R1);
    bf16_t* hid = (bf16_t*)(ws + OFF_R2);
    bf16_t* zb = (bf16_t*)P_.out;
    bf16_t* z3 = (bf16_t*)(ws + OFF_R3);

    { const Params pl = load_params(PQ_); prologue_phase(wsg, lds, pl); }
    cg::this_grid().sync();
    asm volatile("" : "+s"(wsg) :: "memory");
    { EpiSwiGLU e{hid}; pg8::gemm_phase<NFF1, DM, DM>(wsg, lds, actb, (const bf16_t*)(ws + OFF_W13_1), e); }
    GSYNC();
    asm volatile("" : "+s"(wsg) :: "memory");
    { EpiZ1 e{P_.in[I_X], zb, 0.5f}; pg8::gemm_phase<DM, DFFP, DFFP>(wsg, lds, hid, (const bf16_t*)(ws + OFF_W2_1), e); }
    GSYNC();
    lnz_phase(wsg, zb, P_.in[I_LN1G], P_.in[I_LN1B], (bf16_t*)P_.out + (size_t)T_TOK * DM, nullptr, (float*)(ws + OFF_STAT1));
    GSYNC();
    bf16_t* proj = (bf16_t*)(ws + OFF_R3);
    bf16_t* lin = (bf16_t*)(ws + OFF_R1); bf16_t* qn = (bf16_t*)(ws + OFF_R1 + 48 * MiB); bf16_t* kvn = (bf16_t*)(ws + OFF_R1 + 96 * MiB);
    bf16_t* yr = (bf16_t*)(ws + OFF_R1); bf16_t* ym = (bf16_t*)(ws + OFF_R1 + 64 * MiB);
    bf16_t* qbuf = (bf16_t*)(ws + OFF_R2 + 192 * MiB);
    bf16_t* kn = (bf16_t*)(ws + OFF_R4); bf16_t* vt = (bf16_t*)(ws + OFF_R4 + 64 * MiB); bf16_t* kpe = (bf16_t*)(ws + OFF_R4 + 128 * MiB);
    bf16_t* h1b = (bf16_t*)P_.out + (size_t)T_TOK * DM;
    bf16_t* ubuf = (bf16_t*)(ws + OFF_R2 + 128 * MiB); bf16_t* gates = (bf16_t*)(ws + OFF_R3);
    unsigned* ctl = (unsigned*)(ws + OFF_CTL);
    asm volatile("" : "+s"(wsg) :: "memory");
    { EpiBf16Store<0> e{proj, PROJ_LD}; pg8::gemm_phase<PROJ_LD, DM, DM>(wsg, lds, (const bf16_t*)P_.out + (size_t)T_TOK * DM, (const bf16_t*)(ws + OFF_WIN), e); }
    GSYNC();
    { const Params pl = load_params(PQ_); prep_phase(wsg, pl); }
    GSYNC();
    asm volatile("" : "+s"(wsg) :: "memory");
    { EpiBf16Store<2> e{qbuf, 768}; pg8::gemm_phase<768, 384, 384>(wsg, lds, qn, (const bf16_t*)(ws + OFF_WQ), e); }
    asm volatile("" : "+s"(wsg) :: "memory");
    { EpiKV e{kn, vt}; pg8::gemm_phase<1024, 256, 256>(wsg, lds, kvn, (const bf16_t*)(ws + OFF_WKV), e); }
    asm volatile("" : "+s"(wsg) :: "memory");
    { EpiLoraAll e{(unsigned short*)(ws + OFF_R2), P_.in[I_W0], P_.in[I_A0]}; pg8::gemm_phase<1536, 384, 384>(wsg, lds, lin, (const bf16_t*)(ws + OFF_WLORA), e); }
    GSYNC();
    if (blockIdx.x < 64) { const Params pl = load_params(PQ_); scan_chain(wsg, lds, pl, (int)blockIdx.x); }
    attn_phase(wsg, lds, qbuf, kn, kpe, vt, ym, ctl, (const float*)(ws + OFF_ROPE));
    GSYNC();
    asm volatile("" : "+s"(wsg) :: "memory");
    { EpiBf16Store<1> e{gates, NGATE}; pg8::gemm_phase<NGATE, DM, DM>(wsg, lds, h1b, (const bf16_t*)(ws + OFF_WIN) + (size_t)PROJ_LD * DM, e); }
    GSYNC();
    asm volatile("" : "+s"(wsg) :: "memory");
    { EpiUp<0> e{ubuf, gates, 0}; pg8::gemm_phase<DM, 512, 512>(wsg, lds, yr, (const bf16_t*)(ws + OFF_WUR), e); }
    asm volatile("" : "+s"(wsg) :: "memory");
    { EpiUp<1> e{ubuf, gates, 1024}; pg8::gemm_phase<DM, 512, 512>(wsg, lds, ym, (const bf16_t*)(ws + OFF_WUM), e); }
    GSYNC();
    asm volatile("" : "+s"(wsg) :: "memory");
    { EpiZLN e{zb, zb, 1.0f, (const float*)(ws + OFF_STAT1), P_.in[I_LN1G], P_.in[I_LN1B]}; pg8::gemm_phase<DM, DM, DM>(wsg, lds, ubuf, (const bf16_t*)(ws + OFF_WO), e); }
    GSYNC();
    lnz_phase(wsg, zb, P_.in[I_LN2G], P_.in[I_LN2B], actb, nullptr, (float*)(ws + OFF_STAT2));
    GSYNC();
    asm volatile("" : "+s"(wsg) :: "memory");
    { EpiSwiGLU e{hid}; pg8::gemm_phase<NFF1, DM, DM>(wsg, lds, actb, (const bf16_t*)(ws + OFF_W13_2), e); }
    GSYNC();
    asm volatile("" : "+s"(wsg) :: "memory");
    { EpiZLN e{zb, z3, 0.5f, (const float*)(ws + OFF_STAT2), P_.in[I_LN2G], P_.in[I_LN2B]}; pg8::gemm_phase<DM, DFFP, DFFP>(wsg, lds, hid, (const bf16_t*)(ws + OFF_W2_2), e); }
    GSYNC();
    lnz_phase(wsg, z3, P_.in[I_LN3G], P_.in[I_LN3B], nullptr, P_.out, nullptr);
}

extern "C" void kernel_launch(void* const* d_in, const int* in_sizes, int n_in, void* d_out, int out_size, void* d_ws, size_t ws_size, hipStream_t stream) {
    static int grid = 0;
    if (grid == 0) {
        int dev = 0, cus = 0, per_cu = 0;
        hipGetDevice(&dev);
        hipDeviceGetAttribute(&cus, hipDeviceAttributeMultiprocessorCount, dev);
        if (hipFuncSetAttribute((const void*)mk_fwd, hipFuncAttributeMaxDynamicSharedMemorySize, LDS_BYTES) != hipSuccess) fprintf(stderr, "hipFuncSetAttribute failed\n");
        hipOccupancyMaxActiveBlocksPerMultiprocessor(&per_cu, (const void*)mk_fwd, 512, LDS_BYTES);
        if (per_cu < 1) { fprintf(stderr, "occupancy query says %d blocks/CU\n", per_cu); per_cu = 1; }
        grid = cus;
        if (ws_size < 1024 * MiB) fprintf(stderr, "workspace too small: %zu\n", ws_size);
    }
    Params p{};
    for (int i = 0; i < 32; ++i) p.in[i] = (const float*)d_in[i];
    p.out = (float*)d_out; p.ws = (unsigned char*)d_ws;
    hipMemsetAsync((unsigned char*)d_ws + OFF_CTL, 0, CTL_BYTES, stream);
    void* args[] = {&p};
    hipError_t e = hipLaunchCooperativeKernel((const void*)mk_fwd, dim3(grid), dim3(512), args, LDS_BYTES, stream);
    if (e != hipSuccess) fprintf(stderr, "cooperative launch failed: %s (grid %d)\n", hipGetErrorString(e), grid);
}
```
